# Optimizing an MI355X kernel written in HIP

```python
import jax, jax.numpy as jnp
from jax import lax
import numpy as np

D_MODEL = 2048
BATCH = 4
SEQ = 4096
DEPTH = 1

CHUNK = 64
D_MIX = D_MODEL
SB_WIDTH = D_MIX // 2
LRU_WIDTH = D_MIX - SB_WIDTH
SB_HEAD_DIM = 128
SB_HEADS = SB_WIDTH // SB_HEAD_DIM
LRU_BLOCKS = 8
LRU_BLOCK_DIM = LRU_WIDTH // LRU_BLOCKS
CONV_WIDTH = 4
LRU_C = 8.0
Q_BLOCK = 128
EPS = 1e-6
D_IN = 4 * SB_WIDTH + 2 * LRU_WIDTH

kernel_name = "hybrid_stickbreaking_rglru_block"


def rmsnorm(x, gain):
    xf = x.astype(jnp.float32)
    y = xf * lax.rsqrt(jnp.mean(xf * xf, axis=-1, keepdims=True) + EPS)
    return (y * gain.astype(jnp.float32)).astype(x.dtype)


def stick_breaking_attention(q, k, v):
    B, H, S, Dh = q.shape
    n_blk = S // Q_BLOCK
    q_blocks = q.reshape(B, H, n_blk, Q_BLOCK, Dh).transpose(2, 0, 1, 3, 4)
    k_pos = jnp.arange(S, dtype=jnp.int32)
    scale = Dh ** -0.5

    def one_block(args):
        q_blk, blk = args
        z = jnp.einsum('bhqd,bhkd->bhqk', q_blk, k).astype(jnp.float32) * scale
        q_pos = blk * Q_BLOCK + jnp.arange(Q_BLOCK, dtype=jnp.int32)
        mask = k_pos[None, :] < q_pos[:, None]
        log_fail = jnp.where(mask, jax.nn.log_sigmoid(-z), 0.0)
        after = lax.cumsum(log_fail, axis=3, reverse=True) - log_fail
        log_w = jax.nn.log_sigmoid(z) + after
        w = jnp.where(mask, jnp.exp(log_w), 0.0)
        return jnp.einsum('bhqk,bhkd->bhqd', w.astype(v.dtype), v)

    out = lax.map(one_block, (q_blocks, jnp.arange(n_blk, dtype=jnp.int32)))
    return out.transpose(1, 2, 0, 3, 4).reshape(B, H, S, Dh)


def causal_depthwise_conv(x, w, b):
    S = x.shape[1]
    xp = jnp.pad(x, ((0, 0), (CONV_WIDTH - 1, 0), (0, 0)))
    out = xp[:, 0:S, :] * w[0]
    for i in range(1, CONV_WIDTH):
        out = out + xp[:, i:i + S, :] * w[i]
    return out + b


def rg_lru(x, w_a, b_a, w_x, b_x, lam):
    B, S, C = x.shape
    xb = x.reshape(B, S, LRU_BLOCKS, LRU_BLOCK_DIM)
    r = jax.nn.sigmoid(jnp.einsum('bsgi,gij->bsgj', xb, w_a).reshape(B, S, C) + b_a)
    i = jax.nn.sigmoid(jnp.einsum('bsgi,gij->bsgj', xb, w_x).reshape(B, S, C) + b_x)
    log_a = -LRU_C * r.astype(jnp.float32) * jax.nn.softplus(-lam.astype(jnp.float32))
    a = jnp.exp(log_a)
    u = jnp.sqrt(-jnp.expm1(2.0 * log_a)) * (i * x).astype(jnp.float32)

    def combine(left, right):
        a_l, b_l = left
        a_r, b_r = right
        return a_l * a_r, a_r * b_l + b_r

    _, h = lax.associative_scan(combine, (a, u), axis=1)
    return h.astype(x.dtype)


def setup_inputs(seed: int = 0) -> dict:
    key = jax.random.key(seed)
    ks = jax.random.split(key, 14)
    L = DEPTH
    x = jax.random.normal(ks[0], (BATCH, SEQ, D_MODEL), jnp.float32)
    norm_gain = 1.0 + 0.02 * jax.random.normal(ks[1], (L, D_MODEL), jnp.float32)
    w_in = jax.random.normal(ks[2], (L, D_MODEL, D_IN), jnp.float32) * D_MODEL ** -0.5
    q_norm_gain = 1.0 + 0.02 * jax.random.normal(ks[3], (L, SB_HEAD_DIM), jnp.float32)
    k_norm_gain = 1.0 + 0.02 * jax.random.normal(ks[4], (L, SB_HEAD_DIM), jnp.float32)
    conv_w = jax.random.normal(ks[5], (L, CONV_WIDTH, LRU_WIDTH), jnp.float32) * CONV_WIDTH ** -0.5
    conv_b = 0.01 * jax.random.normal(ks[6], (L, LRU_WIDTH), jnp.float32)
    lru_w_a = jax.random.normal(ks[7], (L, LRU_BLOCKS, LRU_BLOCK_DIM, LRU_BLOCK_DIM), jnp.float32) * LRU_BLOCK_DIM ** -0.5
    lru_b_a = 0.01 * jax.random.normal(ks[8], (L, LRU_WIDTH), jnp.float32)
    lru_w_x = jax.random.normal(ks[9], (L, LRU_BLOCKS, LRU_BLOCK_DIM, LRU_BLOCK_DIM), jnp.float32) * LRU_BLOCK_DIM ** -0.5
    lru_b_x = 0.01 * jax.random.normal(ks[10], (L, LRU_WIDTH), jnp.float32)
    u = jax.random.uniform(ks[11], (L, LRU_WIDTH), jnp.float32, minval=0.9, maxval=0.999)
    s = u ** (1.0 / LRU_C)
    lru_lambda = jnp.log(s) - jnp.log1p(-s)
    w_out = jax.random.normal(ks[12], (L, D_MIX, D_MODEL), jnp.float32) * D_MIX ** -0.5
    return {"x": x, "norm_gain": norm_gain, "w_in": w_in, "q_norm_gain": q_norm_gain,
            "k_norm_gain": k_norm_gain, "conv_w": conv_w, "conv_b": conv_b,
            "lru_w_a": lru_w_a, "lru_b_a": lru_b_a, "lru_w_x": lru_w_x, "lru_b_x": lru_b_x,
            "lru_lambda": lru_lambda, "w_out": w_out}


def reference(x, norm_gain, w_in, q_norm_gain, k_norm_gain, conv_w, conv_b,
              lru_w_a, lru_b_a, lru_w_x, lru_b_x, lru_lambda, w_out):
    B, S, _ = x.shape
    h = x
    for l in range(DEPTH):
        xn = rmsnorm(h, norm_gain[l])
        proj = jnp.einsum('bsd,de->bse', xn, w_in[l])
        q, k, v, g_sb, x_lru, g_lru = jnp.split(
            proj, np.cumsum([SB_WIDTH] * 4 + [LRU_WIDTH]).tolist(), axis=-1)

        def heads(t):
            return t.reshape(B, S, SB_HEADS, SB_HEAD_DIM)
        qh = rmsnorm(heads(q), q_norm_gain[l]).transpose(0, 2, 1, 3)
        kh = rmsnorm(heads(k), k_norm_gain[l]).transpose(0, 2, 1, 3)
        vh = heads(v).transpose(0, 2, 1, 3)
        y_sb = stick_breaking_attention(qh, kh, vh).transpose(0, 2, 1, 3).reshape(B, S, SB_WIDTH)
        y_sb = y_sb * jax.nn.silu(g_sb)

        xc = causal_depthwise_conv(x_lru, conv_w[l], conv_b[l])
        y_lru = rg_lru(xc, lru_w_a[l], lru_b_a[l], lru_w_x[l], lru_b_x[l], lru_lambda[l])
        y_lru = y_lru * jax.nn.silu(g_lru)

        y = jnp.concatenate([y_sb, y_lru], axis=-1)
        h = h + jnp.einsum('bse,ed->bsd', y, w_out[l])
    return h
```

```cpp
#include <hip/hip_runtime.h>
#include <hip/hip_cooperative_groups.h>
#include <cstdio>
namespace cg = cooperative_groups;
namespace pg8 {
#define PG8_LAS __attribute__((address_space(3)))
typedef unsigned short bf16_t;
typedef short bf16x8 __attribute__((ext_vector_type(8)));
typedef float f32x4 __attribute__((ext_vector_type(4)));
typedef unsigned u32x4 __attribute__((ext_vector_type(4)));
constexpr int BM = 256, BK = 64, HALF = 128, HTB = HALF * BK * 2  , STAGE_BYTES = 8 * HTB, NXCD = 8, WGM = 8;

__host__ __device__ __forceinline__ int lds_byte(int r, int c) { const int st = (r >> 4) * 2 + (c >> 5), rr = r & 15, cc = c & 31, ob = rr * 64 + cc * 2; return st * 1024 + (ob ^ (((ob >> 9) & 1) << 5)); }
__host__ __device__ __forceinline__ void stage_rc(int b, int& R, int& C) { const int st = b / 1024, sb = b % 1024, swz = sb ^ (((sb >> 9) & 1) << 5); R = (st >> 1) * 16 + swz / 64; C = (st & 1) * 32 + (swz % 64) / 2; }
__host__ __device__ __forceinline__ int perm32(int rho) { const int n = rho >> 4, i = rho & 15; return 8 * (i >> 2) + 4 * n + (i & 3); }

struct Unit { int pm, pn; };
struct Gemm { const bf16_t* A; const bf16_t* Bt; int M, N, K; };

struct StaticOrder {
    int nM, nN, nwg, G, c;
    __host__ __device__ void init(int M, int N, int G_, int c_) { nM = M / BM; nN = N / BM; nwg = nM * nN; G = G_; c = c_; }
    __host__ __device__ bool next(int i, Unit& u) const {
        const long L = (long)i * G + c; if (L >= nwg) return false;
        int wgid = (int)L; { const int q = nwg / NXCD, r = nwg % NXCD, xcd = wgid % NXCD, off = wgid / NXCD; wgid = (xcd < r ? xcd * (q + 1) : r * (q + 1) + (xcd - r) * q) + off; }
        const int nig = WGM * nN, gid = wgid / nig, fm = gid * WGM, gsz = (nM - fm) < WGM ? (nM - fm) : WGM;
        u.pm = fm + ((wgid % nig) % gsz); u.pn = (wgid % nig) / gsz; return true;
    }
    __device__ __forceinline__ void a_ready(const Unit&) const {}
    __device__ __forceinline__ void done(const Unit&) const {}
};
typedef float f32x2 __attribute__((ext_vector_type(2)));
typedef __bf16 b16x2 __attribute__((ext_vector_type(2)));
typedef unsigned u32x2 __attribute__((ext_vector_type(2)));
__device__ __forceinline__ unsigned pk2(float lo, float hi) { f32x2 v = {lo, hi}; b16x2 b = __builtin_convertvector(v, b16x2); return __builtin_bit_cast(unsigned, b); }
struct EpiResF32 {
    static constexpr bool PERM = false, AFTER_DRAIN = false;
    float* C; const float* base; int ldc;
    __device__ __forceinline__ void operator()(const f32x4 (&acc)[2][2][4][2], const Unit& u, int wr, int wc, int fr, int fq) const {
        const int row0 = u.pm * BM + wr * 64 + fr, col0 = u.pn * BM + wc * 32 + 4 * fq;
        f32x4 bs[4][2][2];
#pragma unroll
        for (int m = 0; m < 4; ++m) { const size_t off = (size_t)(row0 + m * 16) * ldc + col0;
#pragma unroll
            for (int bj = 0; bj < 2; ++bj)
#pragma unroll
                for (int n = 0; n < 2; ++n) bs[m][bj][n] = __builtin_nontemporal_load((const f32x4*)(base + off + bj * HALF + n * 16)); }
#pragma unroll
        for (int m = 0; m < 4; ++m) { const size_t off = (size_t)(row0 + m * 16) * ldc + col0, off1 = off + (size_t)HALF * ldc;
#pragma unroll
            for (int bj = 0; bj < 2; ++bj)
#pragma unroll
                for (int n = 0; n < 2; ++n) { *(f32x4*)(C + off + bj * HALF + n * 16) = acc[0][bj][m][n] + bs[m][bj][n];
                    bs[m][bj][n] = __builtin_nontemporal_load((const f32x4*)(base + off1 + bj * HALF + n * 16)); } }
#pragma unroll
        for (int m = 0; m < 4; ++m) { const size_t off1 = (size_t)(row0 + HALF + m * 16) * ldc + col0;
#pragma unroll
            for (int bj = 0; bj < 2; ++bj)
#pragma unroll
                for (int n = 0; n < 2; ++n) *(f32x4*)(C + off1 + bj * HALF + n * 16) = acc[1][bj][m][n] + bs[m][bj][n]; }
    }
};
struct EpiBf16Plain {
    static constexpr bool PERM = true, AFTER_DRAIN = false;
    bf16_t* O; int ldc;
    __device__ __forceinline__ void operator()(const f32x4 (&acc)[2][2][4][2], const Unit& u, int wr, int wc, int fr, int fq) const {
        const int row0 = u.pm * BM + wr * 64 + fr, col0 = u.pn * BM + wc * 32 + 8 * fq;
#pragma unroll
        for (int ai = 0; ai < 2; ++ai)
#pragma unroll
            for (int m = 0; m < 4; ++m) { bf16_t* rowp = O + (size_t)(row0 + ai * HALF + m * 16) * ldc + col0;
#pragma unroll
                for (int bj = 0; bj < 2; ++bj) { const f32x4 v0 = acc[ai][bj][m][0], v1 = acc[ai][bj][m][1];
                    u32x4 w; w.x = pk2(v0[0], v0[1]); w.y = pk2(v0[2], v0[3]); w.z = pk2(v1[0], v1[1]); w.w = pk2(v1[2], v1[3]);
                    *(u32x4*)(rowp + bj * HALF) = w; } }
    }
};
struct EpiVt {
    static constexpr bool PERM = true, AFTER_DRAIN = false;
    bf16_t* O;
    __device__ __forceinline__ void operator()(const f32x4 (&acc)[2][2][4][2], const Unit& u, int wr, int wc, int fr, int fq) const {
#pragma unroll
        for (int ai = 0; ai < 2; ++ai)
#pragma unroll
            for (int m = 0; m < 4; ++m) { const int dfull = u.pm * BM + ai * HALF + wr * 64 + m * 16 + fr;
#pragma unroll
                for (int bj = 0; bj < 2; ++bj) { const int tb = u.pn * 8 + bj * 4 + wc, hd = dfull >> 7, dt = (dfull >> 5) & 3, rr = dfull & 31;
                    bf16_t* p = O + ((size_t)(((tb >> 7) * 8 + hd) * 128 + (tb & 127))) * 4096 + (((dt * 2 + (fq >> 1)) * 2) * 32 + rr) * 8 + (fq & 1) * 4;
                    const f32x4 v0 = acc[ai][bj][m][0], v1 = acc[ai][bj][m][1];
                    u32x2 w0, w1; w0.x = pk2(v0[0], v0[1]); w0.y = pk2(v0[2], v0[3]); w1.x = pk2(v1[0], v1[1]); w1.y = pk2(v1[2], v1[3]);
                    *(u32x2*)p = w0; *(u32x2*)(p + 256) = w1; } }
    }
};
struct EpiInProj {
    static constexpr bool PERM = true, AFTER_DRAIN = false;
    bf16_t* out0; size_t seg_stride; const float* qg; const float* kg; PG8_LAS float* P; float qscale, eps;
    __device__ __forceinline__ void operator()(const f32x4 (&acc)[2][2][4][2], const Unit& u, int wr, int wc, int fr, int fq) const {
        const int seg = u.pn >> 2, colt = (u.pn & 3) * BM;
        bf16_t* O = out0 + (size_t)seg * seg_stride;
        const int row0 = u.pm * BM + wr * 64 + fr, col0 = colt + wc * 32 + 8 * fq;
        if (seg >= 2) {
#pragma unroll
            for (int ai = 0; ai < 2; ++ai)
#pragma unroll
                for (int m = 0; m < 4; ++m) { bf16_t* rowp = O + (size_t)(row0 + ai * HALF + m * 16) * 1024 + col0;
#pragma unroll
                    for (int bj = 0; bj < 2; ++bj) { const f32x4 v0 = acc[ai][bj][m][0], v1 = acc[ai][bj][m][1];
                        u32x4 w; w.x = pk2(v0[0], v0[1]); w.y = pk2(v0[2], v0[3]); w.z = pk2(v1[0], v1[1]); w.w = pk2(v1[2], v1[3]);
                        *(u32x4*)(rowp + bj * HALF) = w; } }
            return;
        }
#pragma unroll
        for (int ai = 0; ai < 2; ++ai)
#pragma unroll
            for (int m = 0; m < 4; ++m)
#pragma unroll
                for (int bj = 0; bj < 2; ++bj) { const f32x4 a = acc[ai][bj][m][0], b = acc[ai][bj][m][1];
                    float s = (a[0] * a[0] + a[1] * a[1]) + (a[2] * a[2] + a[3] * a[3]) + (b[0] * b[0] + b[1] * b[1]) + (b[2] * b[2] + b[3] * b[3]);
                    s += __shfl_xor(s, 16); s += __shfl_xor(s, 32);
                    if (fq == 0) P[(ai * HALF + wr * 64 + m * 16 + fr) * 8 + bj * 4 + wc] = s; }
        asm volatile("s_waitcnt lgkmcnt(0)" ::: "memory"); __builtin_amdgcn_s_barrier(); asm volatile("" ::: "memory");
        const float* gp = (seg == 0 ? qg : kg) + wc * 32 + 8 * fq;
        const f32x4 g0 = *(const f32x4*)gp, g1 = *(const f32x4*)(gp + 4);
        const float sc = seg == 0 ? qscale : 1.0f;
#pragma unroll
        for (int ai = 0; ai < 2; ++ai)
#pragma unroll
            for (int m = 0; m < 4; ++m) { const int tokrow = row0 + ai * HALF + m * 16, bb = tokrow >> 12, ss = tokrow & 4095;
#pragma unroll
                for (int bj = 0; bj < 2; ++bj) {
                    bf16_t* rowp = O + ((size_t)((bb * 8 + (u.pn & 3) * 2 + bj) * 128 + (ss >> 5))) * 4096 + (((2 * wc + (fq >> 1)) * 2 + (fq & 1)) * 32 + (ss & 31)) * 8 - bj * HALF;
                    const f32x4 p4 = *(const PG8_LAS f32x4*)(P + (ai * HALF + wr * 64 + m * 16 + fr) * 8 + bj * 4);
                    const float tot = (p4[0] + p4[1]) + (p4[2] + p4[3]);
                    const float rs = __builtin_amdgcn_rsqf(tot * (1.0f / 128.0f) + eps) * sc;
                    const f32x4 v0 = acc[ai][bj][m][0] * rs * g0, v1 = acc[ai][bj][m][1] * rs * g1;
                    u32x4 w; w.x = pk2(v0[0], v0[1]); w.y = pk2(v0[2], v0[3]); w.z = pk2(v1[0], v1[1]); w.w = pk2(v1[2], v1[3]);
                    *(u32x4*)(rowp + bj * HALF) = w; } }
    }
};
struct InProjOrder : StaticOrder {
    __host__ __device__ bool next(int i, Unit& u) const { if (!StaticOrder::next(i, u)) return false; if (u.pn >= 8) u.pn += 4; return true; }
};
template <class Epi, class Sched, bool ALIGN_EPI = false, bool SP2 = false>
__device__ __forceinline__ void gemm_phase(PG8_LAS unsigned char* lds, const Gemm g, const Sched& S, const Epi& E) {
    const int tid = threadIdx.x, wid = __builtin_amdgcn_readfirstlane(tid >> 6), lane = tid & 63, wr = wid >> 2, wc = wid & 3, fr = lane & 15, fq = lane >> 4;
    const int K = g.K, nt = K / BK;
    unsigned voffA[2], voffB[2];
#pragma unroll
    for (int i = 0; i < 2; ++i) { int R, C; stage_rc(tid * 16 + i * 8192, R, C); const int Rb = Epi::PERM ? ((R & ~31) + perm32(R & 31)) : R;
        voffA[i] = (unsigned)(R * K + C) * 2u; voffB[i] = (unsigned)(Rb * K + C) * 2u; }
    const size_t kstep = (size_t)(BK * 2);
    const size_t hstep = (size_t)HALF * K * 2;
    const size_t tstep = 2 * hstep;
    const unsigned ldsw = (unsigned)wid * 1024u;
    const int aoff = lds_byte(wr * 64 + fr, fq * 8), boff = lds_byte(wc * 32 + fr, fq * 8);
#define PG8_SA(b, h) (((b) * 2 + (h)) * HTB)
#define PG8_SB(b, h) ((4 + (b) * 2 + (h)) * HTB)
#define PG8_STAGE(bufoff, gbase, voff) do { _Pragma("unroll") for (int _i = 0; _i < 2; ++_i) \
        __builtin_amdgcn_global_load_lds((const unsigned*)((const char*)(gbase) + (voff)[_i]), (PG8_LAS unsigned*)(lds + (bufoff) + ldsw + _i * 8192), 16, 0, 0); } while (0)
#define PG8_LDA(dst, b, h) do { _Pragma("unroll") for (int m = 0; m < 4; ++m) _Pragma("unroll") for (int k = 0; k < 2; ++k) dst[m][k] = *(const PG8_LAS bf16x8*)(lds + PG8_SA(b, h) + aoff + m * 2048 + k * 1024); } while (0)
#define PG8_LDB(dst, b, h) do { _Pragma("unroll") for (int n = 0; n < 2; ++n) _Pragma("unroll") for (int k = 0; k < 2; ++k) dst[n][k] = *(const PG8_LAS bf16x8*)(lds + PG8_SB(b, h) + boff + n * 2048 + k * 1024); } while (0)
#define PG8_MMA(ai, bj, At, Bt) do { __builtin_amdgcn_s_setprio(1); _Pragma("unroll") for (int m = 0; m < 4; ++m) _Pragma("unroll") for (int n = 0; n < 2; ++n) _Pragma("unroll") for (int k = 0; k < 2; ++k) \
        acc[ai][bj][m][n] = __builtin_amdgcn_mfma_f32_16x16x32_bf16(Bt[n][k], At[m][k], acc[ai][bj][m][n], 0, 0, 0); __builtin_amdgcn_s_setprio(0); } while (0)
#define PG8_WAIT_V(n) asm volatile("s_waitcnt vmcnt(" #n ")" ::: "memory")
#define PG8_WAIT_L(n) asm volatile("s_waitcnt lgkmcnt(" #n ")" ::: "memory")
#define PG8_BAR __builtin_amdgcn_s_barrier()
#define PG8_SCHED __builtin_amdgcn_sched_barrier(0)
    Unit cur, nxt; int ui = 0;
    if (!S.next(0, cur)) return;
    f32x4 acc[2][2][4][2];
#pragma unroll
    for (int a = 0; a < 2; ++a)
#pragma unroll
        for (int b = 0; b < 2; ++b)
#pragma unroll
            for (int m = 0; m < 4; ++m)
#pragma unroll
                for (int n = 0; n < 2; ++n) acc[a][b][m][n] = (f32x4){0.f, 0.f, 0.f, 0.f};
    bf16x8 At[4][2], B0[2][2], B1[2][2];
    const char* cA = (const char*)g.A + (size_t)cur.pm * tstep; const char* cB = (const char*)g.Bt + (size_t)cur.pn * tstep;
    S.a_ready(cur);
    if constexpr (SP2) {
        PG8_STAGE(PG8_SB(0, 0), cB, voffB); PG8_STAGE(PG8_SB(0, 1), cB + hstep, voffB); PG8_STAGE(PG8_SA(0, 0), cA, voffA); PG8_STAGE(PG8_SA(0, 1), cA + hstep, voffA);
        if (wr == 1) PG8_BAR;
        PG8_WAIT_V(2); PG8_BAR;
        PG8_STAGE(PG8_SB(1, 0), cB + kstep, voffB); PG8_STAGE(PG8_SA(1, 0), cA + kstep, voffA); PG8_STAGE(PG8_SB(1, 1), cB + hstep + kstep, voffB);
        PG8_WAIT_V(6); PG8_BAR;
    } else {
        PG8_STAGE(PG8_SB(0, 0), cB, voffB); PG8_STAGE(PG8_SA(0, 0), cA, voffA); PG8_STAGE(PG8_SB(0, 1), cB + hstep, voffB); PG8_STAGE(PG8_SA(0, 1), cA + hstep, voffA);
        if (wr == 1) PG8_BAR;
        PG8_WAIT_V(4); PG8_BAR;
        PG8_STAGE(PG8_SB(1, 0), cB + kstep, voffB); PG8_STAGE(PG8_SA(1, 0), cA + kstep, voffA); PG8_STAGE(PG8_SB(1, 1), cB + hstep + kstep, voffB);
        PG8_WAIT_V(6); PG8_BAR;
    }
    for (;;) {
        const bool has_next = S.next(ui + 1, nxt);
        const char* nA = has_next ? (const char*)g.A + (size_t)nxt.pm * tstep : cA; const char* nB = has_next ? (const char*)g.Bt + (size_t)nxt.pn * tstep : cB;
        for (int t = 0; t < nt; t += 2) {
            const bool last = (t == nt - 2);
            const char* a1 = cA + (size_t)(t + 1) * kstep;
            const char* a2 = last ? nA : cA + (size_t)(t + 2) * kstep; const char* b2 = last ? nB : cB + (size_t)(t + 2) * kstep;
            const char* a3 = a2 + kstep; const char* b3 = b2 + kstep;
            if (last && has_next) S.a_ready(nxt);
            if constexpr (SP2) {
            PG8_LDB(B0, 0, 0); PG8_LDB(B1, 0, 1); PG8_SCHED; PG8_LDA(At, 0, 0); PG8_STAGE(PG8_SA(1, 1), a1 + hstep, voffA);
            PG8_WAIT_V(8); PG8_WAIT_L(0); PG8_BAR; PG8_MMA(0, 0, At, B0); PG8_MMA(0, 1, At, B1); PG8_BAR; PG8_SCHED;
            PG8_LDA(At, 0, 1); PG8_STAGE(PG8_SB(0, 0), b2, voffB); PG8_STAGE(PG8_SB(0, 1), b2 + hstep, voffB); PG8_STAGE(PG8_SA(0, 0), a2, voffA);
            PG8_WAIT_V(8); PG8_WAIT_L(0); PG8_BAR; PG8_MMA(1, 0, At, B0); PG8_MMA(1, 1, At, B1); PG8_BAR; PG8_SCHED;
            PG8_LDB(B0, 1, 0); PG8_LDB(B1, 1, 1); PG8_SCHED; PG8_LDA(At, 1, 0); PG8_STAGE(PG8_SA(0, 1), a2 + hstep, voffA);
            PG8_WAIT_V(8); PG8_WAIT_L(0); PG8_BAR; PG8_MMA(0, 0, At, B0); PG8_MMA(0, 1, At, B1); PG8_BAR; PG8_SCHED;
            PG8_LDA(At, 1, 1); PG8_STAGE(PG8_SB(1, 0), b3, voffB); PG8_STAGE(PG8_SB(1, 1), b3 + hstep, voffB); PG8_STAGE(PG8_SA(1, 0), a3, voffA);
            PG8_WAIT_V(8); PG8_WAIT_L(0); PG8_BAR; PG8_MMA(1, 0, At, B0); PG8_MMA(1, 1, At, B1); PG8_BAR; PG8_SCHED;
            } else {
            PG8_LDB(B0, 0, 0); PG8_SCHED; PG8_LDA(At, 0, 0); PG8_STAGE(PG8_SA(1, 1), a1 + hstep, voffA);
            PG8_WAIT_L(8); PG8_BAR; PG8_WAIT_L(0); PG8_MMA(0, 0, At, B0); PG8_BAR; PG8_SCHED;
            PG8_LDB(B1, 0, 1); PG8_STAGE(PG8_SB(0, 0), b2, voffB);
            PG8_BAR; PG8_WAIT_L(0); PG8_MMA(0, 1, At, B1); PG8_BAR;
            PG8_LDA(At, 0, 1); PG8_STAGE(PG8_SA(0, 0), a2, voffA);
            PG8_BAR; PG8_WAIT_L(0); PG8_MMA(1, 0, At, B0); PG8_BAR; PG8_SCHED;
            PG8_STAGE(PG8_SB(0, 1), b2 + hstep, voffB);
            PG8_WAIT_V(6); PG8_BAR; PG8_MMA(1, 1, At, B1); PG8_BAR;
            PG8_LDB(B0, 1, 0); PG8_SCHED; PG8_LDA(At, 1, 0); PG8_STAGE(PG8_SA(0, 1), a2 + hstep, voffA);
            PG8_WAIT_L(8); PG8_BAR; PG8_WAIT_L(0); PG8_MMA(0, 0, At, B0); PG8_BAR; PG8_SCHED;
            PG8_LDB(B1, 1, 1); PG8_STAGE(PG8_SB(1, 0), b3, voffB);
            PG8_BAR; PG8_WAIT_L(0); PG8_MMA(0, 1, At, B1); PG8_BAR;
            PG8_LDA(At, 1, 1); PG8_STAGE(PG8_SA(1, 0), a3, voffA);
            PG8_BAR; PG8_WAIT_L(0); PG8_MMA(1, 0, At, B0); PG8_BAR; PG8_SCHED;
            PG8_STAGE(PG8_SB(1, 1), b3 + hstep, voffB);
            PG8_WAIT_V(6); PG8_BAR; PG8_MMA(1, 1, At, B1); PG8_BAR;
            }
        }
        if constexpr (ALIGN_EPI) { if (wr == 0) PG8_BAR; }
        if constexpr (!Epi::AFTER_DRAIN) { E(acc, cur, wr, wc, fr, fq); S.done(cur); }
        if (!has_next) break;
#pragma unroll
        for (int a = 0; a < 2; ++a)
#pragma unroll
            for (int b = 0; b < 2; ++b)
#pragma unroll
                for (int m = 0; m < 4; ++m)
#pragma unroll
                    for (int n = 0; n < 2; ++n) acc[a][b][m][n] = (f32x4){0.f, 0.f, 0.f, 0.f};
        cur = nxt; cA = nA; cB = nB; ++ui;
        if constexpr (ALIGN_EPI) { if (wr == 1) PG8_BAR; }
    }
    PG8_WAIT_V(0);
    if constexpr (!ALIGN_EPI) { if (wr == 0) PG8_BAR; }
    PG8_BAR;
    if constexpr (Epi::AFTER_DRAIN) { E.fused(acc, cur, wr, wc, fr, fq, lds, wid, lane); S.done(cur); }
#undef PG8_SA
#undef PG8_SB
#undef PG8_STAGE
#undef PG8_LDA
#undef PG8_LDB
#undef PG8_MMA
#undef PG8_WAIT_V
#undef PG8_WAIT_L
#undef PG8_BAR
#undef PG8_SCHED
}
}
#define GAS __attribute__((address_space(1)))
#define LAS __attribute__((address_space(3)))
typedef unsigned short bf16;
typedef unsigned v4u __attribute__((ext_vector_type(4)));
typedef unsigned v2u __attribute__((ext_vector_type(2)));
typedef float f32x4 __attribute__((ext_vector_type(4)));
typedef float f32x16 __attribute__((ext_vector_type(16)));
typedef short bf16x8 __attribute__((ext_vector_type(8)));
typedef short s16x4 __attribute__((ext_vector_type(4)));
using pg8::pk2;
constexpr int NWAVES = 8, NTHR = 512;
constexpr int DM = 2048, BATCH = 4, SEQ = 4096, T = BATCH * SEQ, DIN = 6144, W = 1024, NH = 8, HD = 128, NG = 8, GD = 128;
constexpr int LCH = 64, NCH = SEQ / LCH;
constexpr float EPS = 1e-6f, LOG2E = 1.4426950408889634f, LN2 = 0.6931471805599453f;
constexpr float QSCALE = 0.08838834764831845f * LOG2E;
constexpr size_t MiB = 1u << 20;
constexpr size_t WS_WIN = 0, WS_WOUT = 24 * MiB, WS_WA = 32 * MiB, WS_WX = WS_WA + 256 * 1024, WS_AAGG = 33 * MiB, WS_HAGG = 34 * MiB;
constexpr size_t WS_BAR = 35 * MiB, BAR_BYTES = 16384;
constexpr size_t WS_XN = 36 * MiB, WS_Q = 100 * MiB, WS_K = 132 * MiB, WS_VT = 164 * MiB, WS_GSB = 196 * MiB, WS_XL = 228 * MiB, WS_GL = 260 * MiB;
constexpr size_t WS_HL = 292 * MiB, WS_PC = 324 * MiB, WS_Y = 356 * MiB, WS_END = 420 * MiB;
constexpr int RING_BYTES = 131072, PTAB_OFF = RING_BYTES, MISC_OFF = PTAB_OFF + 8192, LDS_BYTES = 147456;
static_assert(8 * 16896 <= MISC_OFF, "attention epilogue slices stay below the barrier's LDS words");

#define LDS_WAIT() asm volatile("s_waitcnt lgkmcnt(0)" ::: "memory")
__device__ __forceinline__ float bf2f(unsigned short b) { return __builtin_bit_cast(float, (unsigned)b << 16); }
__device__ __forceinline__ float bflo(unsigned w) { return __builtin_bit_cast(float, w << 16); }
__device__ __forceinline__ float bfhi(unsigned w) { return __builtin_bit_cast(float, w & 0xffff0000u); }
__device__ __forceinline__ float wave_sum(float v) {
#pragma unroll
    for (int o = 1; o < 64; o <<= 1) v += __shfl_xor(v, o);
    return v;
}
__device__ __forceinline__ float sigmoidf_(float x) { return __builtin_amdgcn_rcpf(1.0f + __builtin_amdgcn_exp2f(-x * LOG2E)); }
__device__ __forceinline__ float siluf_(float x) { return x * sigmoidf_(x); }

struct Args { const float* in[13]; float* out; unsigned char* ws; int ph_lo, ph_hi; };

__device__ __forceinline__ void p0_transpose_item(const float* Wm, int K, int N, bf16* WT, LAS float* scr, int item, int lane) {
    const int nblk = N / 32, kb = item / nblk, nb = item % nblk, k0 = 64 * kb, n0 = 32 * nb;
#pragma unroll 8
    for (int i = 0; i < 32; ++i) { const int kk = 2 * i + (lane >> 5); scr[kk * 33 + (lane & 31)] = __builtin_nontemporal_load(Wm + (size_t)(k0 + kk) * N + n0 + (lane & 31)); }
    LDS_WAIT(); asm volatile("" ::: "memory");
    const int c = lane & 7;
#pragma unroll
    for (int j = 0; j < 4; ++j) { const int n = (lane >> 3) + 8 * j; const LAS float* s = scr + (8 * c) * 33 + n;
        v4u o; o.x = pk2(s[0 * 33], s[1 * 33]); o.y = pk2(s[2 * 33], s[3 * 33]); o.z = pk2(s[4 * 33], s[5 * 33]); o.w = pk2(s[6 * 33], s[7 * 33]);
        *(v4u*)(WT + (size_t)(n0 + n) * K + k0 + 8 * c) = o; }
    LDS_WAIT(); asm volatile("" ::: "memory");
}
__device__ __forceinline__ void p0_prep(const Args& a, LAS unsigned char* lds, int wave, int lane) {
    LAS float* scr = (LAS float*)(lds + wave * 16384);
    const int gw = blockIdx.x * NWAVES + wave, NGW = gridDim.x * NWAVES;
    unsigned char* ws = a.ws;
    constexpr int I_IN = (DM / 64) * (DIN / 32), I_OUT = (W * 2 / 64) * (DM / 32), I_G = (GD / 64) * (GD / 32);
    constexpr int NITEMS = I_IN + I_OUT + 2 * NG * I_G;
    for (int it = gw; it < NITEMS; it += NGW) {
        int r = it;
        if (r < I_IN) { p0_transpose_item(a.in[2], DM, DIN, (bf16*)(ws + WS_WIN), scr, r, lane); continue; } r -= I_IN;
        if (r < I_OUT) { p0_transpose_item(a.in[12], 2 * W, DM, (bf16*)(ws + WS_WOUT), scr, r, lane); continue; } r -= I_OUT;
        if (r < NG * I_G) { const int g = r / I_G; p0_transpose_item(a.in[7] + g * GD * GD, GD, GD, (bf16*)(ws + WS_WA) + g * GD * GD, scr, r % I_G, lane); continue; } r -= NG * I_G;
        { const int g = r / I_G; p0_transpose_item(a.in[9] + g * GD * GD, GD, GD, (bf16*)(ws + WS_WX) + g * GD * GD, scr, r % I_G, lane); }
    }
    const float* x = a.in[0]; const float* gain = a.in[1]; bf16* XN = (bf16*)(ws + WS_XN);
    f32x4 gv[8];
#pragma unroll
    for (int j = 0; j < 8; ++j) gv[j] = *((const f32x4*)gain + 64 * j + lane);
    for (int m = gw; m < T; m += NGW) {
        const f32x4* xr = (const f32x4*)(x + (size_t)m * DM) + lane;
        f32x4 v[8]; float s = 0.f;
#pragma unroll
        for (int j = 0; j < 8; ++j) { v[j] = __builtin_nontemporal_load(xr + 64 * j); s += (v[j].x * v[j].x + v[j].y * v[j].y) + (v[j].z * v[j].z + v[j].w * v[j].w); }
        const float rstd = __builtin_amdgcn_rsqf(wave_sum(s) * (1.f / DM) + EPS);
        v2u* o8 = (v2u*)(XN + (size_t)m * DM) + lane;
#pragma unroll
        for (int j = 0; j < 8; ++j) { const f32x4 y = v[j] * rstd * gv[j]; v2u o; o.x = pk2(y.x, y.y); o.y = pk2(y.z, y.w); o8[64 * j] = o; }
    }
}

__device__ __forceinline__ int crow(int reg, int h) { return (reg & 3) + 8 * (reg >> 2) + 4 * h; }
template <bool DIAG>
__device__ __forceinline__ void sb_tile(const f32x16& sc, float& carry, int r, int h, bf16x8 (&pf)[2]) {
    typedef float f2 __attribute__((ext_vector_type(2)));
    f2 m[2][4];
#pragma unroll
    for (int gp = 0; gp < 2; ++gp)
#pragma unroll
        for (int j = 0; j < 4; ++j) { f2 e; e.x = __builtin_amdgcn_exp2f(sc[8 * gp + j]); e.y = __builtin_amdgcn_exp2f(sc[8 * gp + 4 + j]);
            const f2 t = e + 1.0f; f2 v; v.x = __builtin_amdgcn_rcpf(t.x); v.y = __builtin_amdgcn_rcpf(t.y);
            if (DIAG) { if (crow(8 * gp + j, h) >= r) v.x = 1.0f; if (crow(8 * gp + 4 + j, h) >= r) v.y = 1.0f; }
            m[gp][j] = v; }
#pragma unroll
    for (int gp = 0; gp < 2; ++gp) { m[gp][2] *= m[gp][3]; m[gp][1] *= m[gp][2]; m[gp][0] *= m[gp][1]; }
    float tg[4] = {m[0][0].x, m[0][0].y, m[1][0].x, m[1][0].y}, og[4], base[4];
#pragma unroll
    for (int g = 0; g < 4; ++g) { const unsigned tu = __builtin_bit_cast(unsigned, tg[g]); const auto sw = __builtin_amdgcn_permlane32_swap(tu, tu, false, false);
        og[g] = __builtin_bit_cast(float, h == 0 ? sw[1] : sw[0]); }
    float later = carry;
#pragma unroll
    for (int g = 3; g >= 0; --g) { base[g] = h == 0 ? later * og[g] : later; later *= tg[g] * og[g]; }
    carry = later;
    f2 p[2][4];
#pragma unroll
    for (int gp = 0; gp < 2; ++gp) { const f2 bs = {base[2 * gp], base[2 * gp + 1]};
        p[gp][3] = bs * (1.0f - m[gp][3]); p[gp][2] = bs * (m[gp][3] - m[gp][2]); p[gp][1] = bs * (m[gp][2] - m[gp][1]); p[gp][0] = bs * (m[gp][1] - m[gp][0]); }
#pragma unroll
    for (int s = 0; s < 2; ++s) { v4u q; q.x = pk2(p[s][0].x, p[s][1].x); q.y = pk2(p[s][2].x, p[s][3].x); q.z = pk2(p[s][0].y, p[s][1].y); q.w = pk2(p[s][2].y, p[s][3].y); pf[s] = __builtin_bit_cast(bf16x8, q); }
}
__device__ __forceinline__ void attn_tile(const bf16* Qf, const bf16* Kf, const bf16* Vf, const bf16* Gsb, bf16* Y, LAS float* ol, int b, int hd, int qt, int lane) {
    const int r = lane & 31, h = lane >> 5;
    const size_t tok0 = (size_t)b * SEQ;
    const size_t hb = (size_t)(b * NH + hd) * (SEQ / 32) * 4096;
    const bf16* kbase = Kf + hb + lane * 8;
    const bf16* vbase = Vf + hb + lane * 8;
    bf16x8 qf[8], kf[8];
#pragma unroll
    for (int ks = 0; ks < 8; ++ks) qf[ks] = *(const bf16x8*)(Qf + hb + (size_t)qt * 4096 + lane * 8 + ks * 512);
#pragma unroll
    for (int ks = 0; ks < 8; ++ks) kf[ks] = *(const bf16x8*)(kbase + (size_t)qt * 4096 + ks * 512);
    f32x16 o[4];
#pragma unroll
    for (int dt = 0; dt < 4; ++dt)
#pragma unroll
        for (int i = 0; i < 16; ++i) o[dt][i] = 0.f;
    float carry = 1.0f;
    f32x16 sa, sb;
#pragma unroll
    for (int i = 0; i < 16; ++i) sa[i] = 0.f;
#pragma unroll
    for (int ks = 0; ks < 8; ++ks) sa = __builtin_amdgcn_mfma_f32_32x32x16_bf16(kf[ks], qf[ks], sa, 0, 0, 0);
    { const int kn = qt > 0 ? qt - 1 : 0;
#pragma unroll
      for (int ks = 0; ks < 8; ++ks) kf[ks] = *(const bf16x8*)(kbase + (size_t)kn * 4096 + ks * 512); }
#define ATT_ITER(SCUR, SNXT) { \
        bf16x8 vf[4][2]; \
        _Pragma("unroll") for (int dt = 0; dt < 4; ++dt) _Pragma("unroll") for (int s = 0; s < 2; ++s) vf[dt][s] = *(const bf16x8*)(vbase + (size_t)kt * 4096 + (dt * 2 + s) * 512); \
        _Pragma("unroll") for (int i = 0; i < 16; ++i) SNXT[i] = 0.f; \
        _Pragma("unroll") for (int ks = 0; ks < 8; ++ks) SNXT = __builtin_amdgcn_mfma_f32_32x32x16_bf16(kf[ks], qf[ks], SNXT, 0, 0, 0);     \
        { const int kn = kt > 1 ? kt - 2 : 0; \
          _Pragma("unroll") for (int ks = 0; ks < 8; ++ks) kf[ks] = *(const bf16x8*)(kbase + (size_t)kn * 4096 + ks * 512); } \
        bf16x8 pf[2]; \
        if (kt == qt) sb_tile<true>(SCUR, carry, r, h, pf); else sb_tile<false>(SCUR, carry, r, h, pf); \
        _Pragma("unroll") for (int dt = 0; dt < 4; ++dt) _Pragma("unroll") for (int s = 0; s < 2; ++s) o[dt] = __builtin_amdgcn_mfma_f32_32x32x16_bf16(vf[dt][s], pf[s], o[dt], 0, 0, 0); \
        if (__all(carry == 0.0f)) break; \
        if (--kt < 0) break; }
    for (int kt = qt; ; ) {
        ATT_ITER(sa, sb)
        ATT_ITER(sb, sa)
    }
#undef ATT_ITER
#pragma unroll
    for (int dt = 0; dt < 4; ++dt)
#pragma unroll
        for (int g = 0; g < 4; ++g) *(LAS f32x4*)(ol + r * 132 + 32 * dt + 8 * g + 4 * h) = (f32x4){o[dt][4 * g], o[dt][4 * g + 1], o[dt][4 * g + 2], o[dt][4 * g + 3]};
    { const int rw = lane >> 4, ch = lane & 15;
      const size_t tokb = tok0 + qt * 32;
      v4u gv[8];
#pragma unroll
      for (int ps = 0; ps < 8; ++ps) gv[ps] = *(const v4u*)(Gsb + (tokb + 4 * ps + rw) * W + hd * HD + 8 * ch);
#pragma unroll
      for (int ps = 0; ps < 8; ++ps) { const LAS float* op = ol + (4 * ps + rw) * 132 + 8 * ch;
          const f32x4 o0 = *(const LAS f32x4*)op, o1 = *(const LAS f32x4*)(op + 4);
          const v4u gw = gv[ps]; v4u ov;
          ov.x = pk2(o0[0] * siluf_(bflo(gw.x)), o0[1] * siluf_(bfhi(gw.x))); ov.y = pk2(o0[2] * siluf_(bflo(gw.y)), o0[3] * siluf_(bfhi(gw.y)));
          ov.z = pk2(o1[0] * siluf_(bflo(gw.z)), o1[1] * siluf_(bfhi(gw.z))); ov.w = pk2(o1[2] * siluf_(bflo(gw.w)), o1[3] * siluf_(bfhi(gw.w)));
          *(v4u*)(Y + (tokb + 4 * ps + rw) * (2 * W) + hd * HD + 8 * ch) = ov; } }
}
__device__ __forceinline__ void p2_attention(const Args& a, LAS unsigned char* lds, int wave, int lane) {
    unsigned char* ws = a.ws;
    const bf16 *Qb = (const bf16*)(ws + WS_Q), *Kb = (const bf16*)(ws + WS_K), *Vt = (const bf16*)(ws + WS_VT), *Gsb = (const bf16*)(ws + WS_GSB); bf16* Y = (bf16*)(ws + WS_Y);
    const int gw = blockIdx.x * NWAVES + wave, NGW = gridDim.x * NWAVES;
    constexpr int NQT = SEQ / 32, NIT = BATCH * NH * NQT;
    for (int it = gw; it < NIT; it += NGW) {
        const int qt = it % NQT, bh = it / NQT;
        attn_tile(Qb, Kb, Vt, Gsb, Y, (LAS float*)(lds + wave * 16896), bh / NH, bh % NH, qt, lane);
    }
}

constexpr int XCB_STRIDE = 136;
constexpr int L_XCB = 0, L_XCF = 20480, L_A = L_XCF + 64 * 128 * 4, L_U = L_A + 64 * 128 * 4, L_SEG = L_U + 64 * 128 * 4;
static_assert(L_SEG + 2 * 8 * 128 * 4 <= RING_BYTES && 64 * XCB_STRIDE * 2 <= L_XCF, "lru lds map");
__device__ __forceinline__ float one_minus_exp(float x, float ex) {
    const float p = -x * (1.0f + x * 0.5f * (1.0f + x * (1.0f / 3.0f) * (1.0f + x * 0.25f * (1.0f + x * 0.2f * (1.0f + x * (1.0f / 6.0f))))));
    return x > -0.3f ? p : 1.0f - ex;
}
constexpr int L_CW = L_SEG + 2 * 8 * 128 * 4;
static_assert(L_CW + 5 * 128 * 4 <= RING_BYTES, "lru lds map (conv weights)");
__device__ __forceinline__ void p2_lru(const Args& a, LAS unsigned char* lds, int tid, int wave, int lane) {
    unsigned char* ws = a.ws;
    const bf16* XL = (const bf16*)(ws + WS_XL);
    LAS bf16* xcb = (LAS bf16*)(lds + L_XCB); LAS float* xcf = (LAS float*)(lds + L_XCF); LAS float* aS = (LAS float*)(lds + L_A); LAS float* uS = (LAS float*)(lds + L_U); LAS float* seg = (LAS float*)(lds + L_SEG);
    LAS float* cw = (LAS float*)(lds + L_CW);
    const float* conv_w = a.in[5]; const float* conv_b = a.in[6];
    const int mt = wave >> 2, nt = wave & 3, r = lane & 31, h = lane >> 5, cl = 32 * nt + r;
    const int tr = tid >> 3, cc = tid & 7;
    constexpr int NITEM = BATCH * NCH * NG;
    int gcur = -1; bf16x8 wfa[8], wfx[8]; float ba_ = 0.f, bx_ = 0.f, sp8 = 0.f;
    v4u xr[2][4];
#define LRU_LOAD_ROWS(ITEM) { const int g_ = (ITEM) % NG, ch_ = ((ITEM) / NG) % NCH, b_ = (ITEM) / (NG * NCH); const size_t t0_ = (size_t)b_ * SEQ + ch_ * LCH; \
        _Pragma("unroll") for (int hh = 0; hh < 2; ++hh) _Pragma("unroll") for (int i = 0; i < 4; ++i) { int dr = tr + i - 3; if (ch_ * LCH + dr < 0) dr = 0; \
            xr[hh][i] = *(const v4u*)(XL + (t0_ + dr) * W + g_ * GD + cc * 16 + hh * 8); } }
    if ((int)blockIdx.x < NITEM) LRU_LOAD_ROWS((int)blockIdx.x)
    for (int item = blockIdx.x; item < NITEM; item += gridDim.x) {
        const int g = item % NG, ch = (item / NG) % NCH, b = item / (NG * NCH);
        const size_t t0 = (size_t)b * SEQ + ch * LCH;
        if (g != gcur) {
            gcur = g;
            const bf16* wa = (const bf16*)(ws + WS_WA) + (size_t)g * GD * GD + cl * GD + 8 * h;
            const bf16* wx = (const bf16*)(ws + WS_WX) + (size_t)g * GD * GD + cl * GD + 8 * h;
#pragma unroll
            for (int ks = 0; ks < 8; ++ks) { wfa[ks] = *(const bf16x8*)(wa + 16 * ks); wfx[ks] = *(const bf16x8*)(wx + 16 * ks); }
            const int cgl = g * GD + cl;
            ba_ = a.in[8][cgl]; bx_ = a.in[10][cgl];
            const float nl = -a.in[11][cgl]; sp8 = -8.0f * (fmaxf(nl, 0.f) + log1pf(__expf(-fabsf(nl))));
            __syncthreads();
            if (tid < 128) {
#pragma unroll
                for (int i = 0; i < 4; ++i) cw[i * 128 + tid] = conv_w[i * W + g * GD + tid];
                cw[512 + tid] = conv_b[g * GD + tid]; }
            __syncthreads();
        }
#pragma unroll
        for (int hh = 0; hh < 2; ++hh) { const int c0 = cc * 16 + hh * 8;
            float accv[8];
            { const f32x4 b0 = *(const LAS f32x4*)(cw + 512 + c0), b1 = *(const LAS f32x4*)(cw + 512 + c0 + 4);
              accv[0] = b0[0]; accv[1] = b0[1]; accv[2] = b0[2]; accv[3] = b0[3]; accv[4] = b1[0]; accv[5] = b1[1]; accv[6] = b1[2]; accv[7] = b1[3]; }
#pragma unroll
            for (int i = 0; i < 4; ++i) { const float mk = (ch * LCH + tr + i - 3 >= 0) ? 1.0f : 0.0f;
                const v4u xv = xr[hh][i];
                const f32x4 w0 = *(const LAS f32x4*)(cw + i * 128 + c0) * mk, w1 = *(const LAS f32x4*)(cw + i * 128 + c0 + 4) * mk;
                accv[0] += bflo(xv.x) * w0[0]; accv[1] += bfhi(xv.x) * w0[1]; accv[2] += bflo(xv.y) * w0[2]; accv[3] += bfhi(xv.y) * w0[3];
                accv[4] += bflo(xv.z) * w1[0]; accv[5] += bfhi(xv.z) * w1[1]; accv[6] += bflo(xv.w) * w1[2]; accv[7] += bfhi(xv.w) * w1[3]; }
            v4u pb; pb.x = pk2(accv[0], accv[1]); pb.y = pk2(accv[2], accv[3]); pb.z = pk2(accv[4], accv[5]); pb.w = pk2(accv[6], accv[7]);
            *(LAS v4u*)(xcb + tr * XCB_STRIDE + c0) = pb;
            *(LAS f32x4*)(xcf + tr * 128 + c0) = (f32x4){accv[0], accv[1], accv[2], accv[3]}; *(LAS f32x4*)(xcf + tr * 128 + c0 + 4) = (f32x4){accv[4], accv[5], accv[6], accv[7]}; }
        __syncthreads();
        { const int nx = item + (int)gridDim.x < NITEM ? item + (int)gridDim.x : item;
          LRU_LOAD_ROWS(nx) }
        { f32x16 R, I;
#pragma unroll
          for (int i = 0; i < 16; ++i) { R[i] = 0.f; I[i] = 0.f; }
#pragma unroll
          for (int ks = 0; ks < 8; ++ks) { const bf16x8 af = *(const LAS bf16x8*)(xcb + (32 * mt + r) * XCB_STRIDE + 16 * ks + 8 * h);
              R = __builtin_amdgcn_mfma_f32_32x32x16_bf16(af, wfa[ks], R, 0, 0, 0); I = __builtin_amdgcn_mfma_f32_32x32x16_bf16(af, wfx[ks], I, 0, 0, 0); }
#pragma unroll
          for (int i = 0; i < 16; i += 2) {
              typedef float f2 __attribute__((ext_vector_type(2)));
              const int tk = 32 * mt + crow(i, h);
              const f2 zr = (f2){R[i], R[i + 1]} + ba_, zi = (f2){I[i], I[i + 1]} + bx_;
              const f2 ar = zr * (-LOG2E), ai = zi * (-LOG2E);
              f2 er, ei; er.x = __builtin_amdgcn_exp2f(ar.x); er.y = __builtin_amdgcn_exp2f(ar.y); ei.x = __builtin_amdgcn_exp2f(ai.x); ei.y = __builtin_amdgcn_exp2f(ai.y);
              const f2 tr2 = er + 1.0f, ti2 = ei + 1.0f;
              f2 rr, ii; rr.x = __builtin_amdgcn_rcpf(tr2.x); rr.y = __builtin_amdgcn_rcpf(tr2.y); ii.x = __builtin_amdgcn_rcpf(ti2.x); ii.y = __builtin_amdgcn_rcpf(ti2.y);
              const f2 log_a = rr * sp8, la2 = log_a * LOG2E;
              f2 av; av.x = __builtin_amdgcn_exp2f(la2.x); av.y = __builtin_amdgcn_exp2f(la2.y);
              const f2 x = log_a * 2.0f;
              const f2 pl = -x * (1.0f + x * 0.5f * (1.0f + x * (1.0f / 3.0f) * (1.0f + x * 0.25f * (1.0f + x * 0.2f * (1.0f + x * (1.0f / 6.0f))))));
              const f2 big = 1.0f - av * av;
              f2 om; om.x = x.x > -0.3f ? pl.x : big.x; om.y = x.y > -0.3f ? pl.y : big.y;
              f2 sq; sq.x = __builtin_amdgcn_sqrtf(om.x); sq.y = __builtin_amdgcn_sqrtf(om.y);
              const f2 xc2 = {xcf[tk * 128 + cl], xcf[(tk + 1) * 128 + cl]};
              const f2 uv = sq * (ii * xc2);
              aS[tk * 128 + cl] = av.x; aS[(tk + 1) * 128 + cl] = av.y; uS[tk * 128 + cl] = uv.x; uS[(tk + 1) * 128 + cl] = uv.y; } }
        __syncthreads();
        { const int cp = tid & 63, sg = tid >> 6;
          typedef float f32x2 __attribute__((ext_vector_type(2)));
          f32x2 hl[8], pl[8]; f32x2 H = {0.f, 0.f}, Pc = {1.f, 1.f};
#pragma unroll
          for (int k = 0; k < 8; ++k) { const f32x2 av = *(const LAS f32x2*)(aS + (8 * sg + k) * 128 + 2 * cp), uv = *(const LAS f32x2*)(uS + (8 * sg + k) * 128 + 2 * cp); H = av * H + uv; Pc *= av; hl[k] = H; pl[k] = Pc; }
          *(LAS f32x2*)(seg + sg * 128 + 2 * cp) = Pc; *(LAS f32x2*)(seg + 1024 + sg * 128 + 2 * cp) = H;
          __syncthreads();
          f32x2 Hin = {0.f, 0.f}, Ain = {1.f, 1.f};
#pragma unroll
          for (int q = 0; q < 7; ++q) if (q < sg) { const f32x2 sa = *(const LAS f32x2*)(seg + q * 128 + 2 * cp), sh = *(const LAS f32x2*)(seg + 1024 + q * 128 + 2 * cp); Hin = sa * Hin + sh; Ain *= sa; }
          unsigned* HL = (unsigned*)((bf16*)(ws + WS_HL) + (t0 + 8 * sg) * W + g * GD + 2 * cp); unsigned* PC = (unsigned*)((bf16*)(ws + WS_PC) + (t0 + 8 * sg) * W + g * GD + 2 * cp);
          f32x2 hlast = {0.f, 0.f}, plast = {0.f, 0.f};
#pragma unroll
          for (int k = 0; k < 8; ++k) { const f32x2 hv = hl[k] + pl[k] * Hin, pv = pl[k] * Ain; hlast = hv; plast = pv;
              HL[(size_t)k * (W / 2)] = pk2(hv.x, hv.y); PC[(size_t)k * (W / 2)] = pk2(pv.x, pv.y); }
          if (sg == 7) { *(f32x2*)((float*)(ws + WS_AAGG) + ((size_t)b * NCH + ch) * W + g * GD + 2 * cp) = plast; *(f32x2*)((float*)(ws + WS_HAGG) + ((size_t)b * NCH + ch) * W + g * GD + 2 * cp) = hlast; } }
        __syncthreads();
    }
#undef LRU_LOAD_ROWS
}

__device__ __forceinline__ void p3_item(const Args& a, LAS unsigned char* lds, int item, int tid) {
    unsigned char* ws = a.ws;
    const int o8 = item % 8, g = (item / 8) % NG, b = item / (8 * NG);
    LAS float* hin = (LAS float*)lds;
    const float* AA = (const float*)(ws + WS_AAGG) + (size_t)b * NCH * W + g * GD; const float* HA = (const float*)(ws + WS_HAGG) + (size_t)b * NCH * W + g * GD;
    const int c8 = (tid & 15) * 8, row = tid >> 4;
    const size_t t0 = (size_t)b * SEQ + (size_t)o8 * 8 * LCH;
    const bf16 *HL = (const bf16*)(ws + WS_HL), *PC = (const bf16*)(ws + WS_PC), *GL = (const bf16*)(ws + WS_GL); bf16* Y = (bf16*)(ws + WS_Y);
    v4u hv[4], pv[4], gv[4];
#define P3_LOAD(PS0) { _Pragma("unroll") for (int q = 0; q < 4; ++q) { const size_t off = (t0 + ((PS0) + q) * 32 + row) * W + g * GD + c8; \
        hv[q] = __builtin_nontemporal_load((const v4u*)(HL + off)); pv[q] = __builtin_nontemporal_load((const v4u*)(PC + off)); gv[q] = __builtin_nontemporal_load((const v4u*)(GL + off)); } }
    P3_LOAD(0)
    {
      const int c = tid & 127, part = tid >> 7; LAS float* pa = hin + 1024; LAS float* ph = hin + 1536;
      const int kbeg = part * 2 * o8, n = 2 * o8;
      float ak[14], hk[14];
#pragma unroll
      for (int i = 0; i < 14; ++i) { const int k = i < n ? kbeg + i : 0; ak[i] = AA[(size_t)k * W + c]; hk[i] = HA[(size_t)k * W + c]; }
      float H = 0.f, A = 1.f;
#pragma unroll
      for (int i = 0; i < 14; ++i) if (i < n) { H = ak[i] * H + hk[i]; A *= ak[i]; }
      pa[part * 128 + c] = A; ph[part * 128 + c] = H;
      float a8[8], h8[8];
#pragma unroll
      for (int k = 0; k < 8; ++k) { a8[k] = AA[(size_t)(8 * o8 + k) * W + c]; h8[k] = HA[(size_t)(8 * o8 + k) * W + c]; }
      __syncthreads();
      if (tid < 128) { float Hc = 0.f;
#pragma unroll
          for (int q = 0; q < 4; ++q) Hc = pa[q * 128 + tid] * Hc + ph[q * 128 + tid];
#pragma unroll
          for (int k = 0; k < 8; ++k) { hin[k * 128 + tid] = Hc; Hc = a8[k] * Hc + h8[k]; } } }
    __syncthreads();
#pragma unroll 1
    for (int pg = 0; pg < 4; ++pg) {
#pragma unroll
        for (int q = 0; q < 4; ++q) { const int tl = (pg * 4 + q) * 32 + row;
            const LAS float* hi = hin + (tl >> 6) * 128 + c8;
            const f32x4 h0 = *(const LAS f32x4*)hi, h1 = *(const LAS f32x4*)(hi + 4);
            const v4u hw = hv[q], pw = pv[q], gw = gv[q];
            float y[8];
            y[0] = (bflo(hw.x) + bflo(pw.x) * h0[0]) * siluf_(bflo(gw.x)); y[1] = (bfhi(hw.x) + bfhi(pw.x) * h0[1]) * siluf_(bfhi(gw.x));
            y[2] = (bflo(hw.y) + bflo(pw.y) * h0[2]) * siluf_(bflo(gw.y)); y[3] = (bfhi(hw.y) + bfhi(pw.y) * h0[3]) * siluf_(bfhi(gw.y));
            y[4] = (bflo(hw.z) + bflo(pw.z) * h1[0]) * siluf_(bflo(gw.z)); y[5] = (bfhi(hw.z) + bfhi(pw.z) * h1[1]) * siluf_(bfhi(gw.z));
            y[6] = (bflo(hw.w) + bflo(pw.w) * h1[2]) * siluf_(bflo(gw.w)); y[7] = (bfhi(hw.w) + bfhi(pw.w) * h1[3]) * siluf_(bfhi(gw.w));
            v4u ov; ov.x = pk2(y[0], y[1]); ov.y = pk2(y[2], y[3]); ov.z = pk2(y[4], y[5]); ov.w = pk2(y[6], y[7]);
            *(v4u*)(Y + (t0 + tl) * (2 * W) + W + g * GD + c8) = ov;
            if (pg < 3) { const size_t off = (t0 + ((pg + 1) * 4 + q) * 32 + row) * W + g * GD + c8;
                hv[q] = __builtin_nontemporal_load((const v4u*)(HL + off)); pv[q] = __builtin_nontemporal_load((const v4u*)(PC + off)); gv[q] = __builtin_nontemporal_load((const v4u*)(GL + off)); } }
    }
#undef P3_LOAD
    __syncthreads();
}

#define XB_TMO      128
#define XB_XCNT(j)  (256  + 64 * (j))
#define XB_XSUB(j)  (1280 + 64 * (j))
#define XB_XGEN(j)  (2304 + 64 * (j))
#define XB_TOP      3328
#define XB_TOPGEN   3392
#define XCD_BAR_WORDS 3456
#define XB_SPIN_CAP (1u << 18)
__device__ __forceinline__ unsigned xb_ld(unsigned* p)              { return __hip_atomic_load(p, __ATOMIC_RELAXED, __HIP_MEMORY_SCOPE_AGENT); }
__device__ __forceinline__ unsigned xb_add(unsigned* p, unsigned v) { return __hip_atomic_fetch_add(p, v, __ATOMIC_RELAXED, __HIP_MEMORY_SCOPE_AGENT); }
__device__ __forceinline__ unsigned xb_xcc_id() { return (unsigned)__builtin_amdgcn_s_getreg((3 << 11) | 20) & 0xFu; }
#define XB_SPIN(cond, bar) do { unsigned _sp = 0; while (cond) { __builtin_amdgcn_s_sleep(1); \
    if ((++_sp & 255u) == 0u) { if (xb_ld(&(bar)[XB_TMO])) break; if (_sp > XB_SPIN_CAP) { atomicAdd(&(bar)[XB_TMO], 1u); break; } } } } while (0)
struct XcdBarrier { unsigned* bar; unsigned x; volatile LAS unsigned* st; };
__device__ __forceinline__ XcdBarrier xcd_barrier_post(unsigned* bar, volatile LAS unsigned* st) {
    XcdBarrier b; b.bar = bar; b.x = xb_xcc_id(); b.st = st;
    if (threadIdx.x == 0) (void)xb_add(&bar[XB_XCNT(b.x)], 1u);
    return b;
}
__device__ __forceinline__ void xcd_barrier_complete(unsigned* bar, unsigned x, unsigned& nloc, unsigned& nx) {
    const unsigned G = gridDim.x * gridDim.y * gridDim.z;
    unsigned sum, cnt, mine, sp = 0u;
    for (;;) {
        sum = 0u; cnt = 0u; mine = 0u;
#pragma unroll
        for (unsigned j = 0; j < 16; ++j) { const unsigned c = xb_ld(&bar[XB_XCNT(j)]); sum += c; cnt += (c > 0u) ? 1u : 0u; mine = (j == x) ? c : mine; }
        if (sum == G) break;
        __builtin_amdgcn_s_sleep(1);
        if ((++sp & 255u) == 0u) { if (xb_ld(&bar[XB_TMO])) break; if (sp > XB_SPIN_CAP) { atomicAdd(&bar[XB_TMO], 1u); break; } }
    }
    nloc = mine > 0u ? mine : 1u; nx = cnt > 0u ? cnt : 1u;
}
__device__ __forceinline__ void xcd_barrier(const XcdBarrier& b) {
    asm volatile("s_waitcnt vmcnt(0)" ::: "memory");
    __syncthreads();
    if (threadIdx.x == 0) {
        unsigned* bar = b.bar;
        __builtin_amdgcn_s_waitcnt(0);
        unsigned nloc = b.st[0], nx = b.st[1];
        if (nloc == 0u) { xcd_barrier_complete(bar, b.x, nloc, nx); b.st[0] = nloc; b.st[1] = nx; }
        const unsigned old = xb_add(&bar[XB_XSUB(b.x)], 1u);
        const unsigned gen = old / nloc;
        if (old + 1u == (gen + 1u) * nloc) {
            __builtin_amdgcn_fence(__ATOMIC_RELEASE, "agent");
            asm volatile("s_waitcnt vmcnt(0)" ::: "memory");
            const unsigned og = xb_add(&bar[XB_TOP], 1u);
            const unsigned tg = og / nx;
            if (og + 1u == (tg + 1u) * nx) xb_add(&bar[XB_TOPGEN], 1u);
            else XB_SPIN(xb_ld(&bar[XB_TOPGEN]) == tg, bar);
            __builtin_amdgcn_fence(__ATOMIC_ACQUIRE, "agent");
            xb_add(&bar[XB_XGEN(b.x)], 1u);
            asm volatile("s_waitcnt vmcnt(0)" ::: "memory");
        } else {
            XB_SPIN(xb_ld(&bar[XB_XGEN(b.x)]) == gen, bar);
            __builtin_amdgcn_fence(__ATOMIC_ACQUIRE, "agent");
            asm volatile("s_waitcnt vmcnt(0)" ::: "memory");
        }
    }
    __syncthreads();
}

#ifndef MK_MULTI
#define MK_MULTI 0
#endif
constexpr int NPHASE = 5;
__global__ void __launch_bounds__(NTHR, 2) hybrid_fwd(Args args) {
    extern __shared__ __attribute__((aligned(16))) unsigned char lds_raw[];
    LAS unsigned char* lds = (LAS unsigned char*)lds_raw;
    const int tid = threadIdx.x, lane = tid & 63, wave = __builtin_amdgcn_readfirstlane(tid >> 6);
    const int lo = args.ph_lo, hi = args.ph_hi;
    unsigned char* ws = args.ws;
#define IN(k) (lo <= (k) && (k) < hi)
    volatile LAS unsigned* misc = (volatile LAS unsigned*)(lds + MISC_OFF);
    if (tid < 4) misc[tid] = 0u;
    __syncthreads();
    const XcdBarrier gbar = xcd_barrier_post((unsigned*)(ws + WS_BAR), misc);
    if (lo < 0) cg::this_grid().sync();
#define SEAM(k) do { if (IN(k) && IN((k) + 1)) { xcd_barrier(gbar); } } while (0)
    if (IN(0)) { p0_prep(args, lds, wave, lane); }
    SEAM(0);
    if (IN(1)) {
        { pg8::Gemm g{(const pg8::bf16_t*)(ws + WS_XN), (const pg8::bf16_t*)(ws + WS_WIN), T, DIN, DM};
          pg8::InProjOrder S; S.init(T, DIN - W, gridDim.x, (int)blockIdx.x);
          static_assert(WS_K - WS_Q == 32 * MiB && WS_GSB - WS_Q == 3 * 32 * MiB && WS_XL - WS_Q == 4 * 32 * MiB && WS_GL - WS_Q == 5 * 32 * MiB, "segment outputs are evenly spaced");
          pg8::EpiInProj E; E.out0 = (pg8::bf16_t*)(ws + WS_Q); E.seg_stride = 16 * MiB;
          E.qg = args.in[3]; E.kg = args.in[4]; E.P = (LAS float*)(lds + PTAB_OFF); E.qscale = QSCALE; E.eps = EPS;
          pg8::gemm_phase<pg8::EpiInProj, pg8::InProjOrder, true, true>(lds, g, S, E); }
        {
          pg8::Gemm g{(const pg8::bf16_t*)(ws + WS_WIN) + (size_t)2 * W * DM, (const pg8::bf16_t*)(ws + WS_XN), W, T, DM};
          pg8::StaticOrder S; S.init(W, T, gridDim.x, (int)blockIdx.x);
          pg8::EpiVt E{(pg8::bf16_t*)(ws + WS_VT)};
          pg8::gemm_phase<pg8::EpiVt, pg8::StaticOrder, true, true>(lds, g, S, E); }
    }
    SEAM(1);
    if (IN(2)) {
        if ((blockIdx.x >> 3) & 1) { p2_lru(args, lds, tid, wave, lane); p2_attention(args, lds, wave, lane); }
        else { p2_attention(args, lds, wave, lane); __syncthreads(); p2_lru(args, lds, tid, wave, lane); }
    }
    SEAM(2);
    if (IN(3)) { for (int it = blockIdx.x; it < BATCH * NG * 8; it += gridDim.x) p3_item(args, lds, it, tid); }
    SEAM(3);
    if (IN(4)) {
        pg8::Gemm g{(const pg8::bf16_t*)(ws + WS_Y), (const pg8::bf16_t*)(ws + WS_WOUT), T, DM, 2 * W};
        pg8::StaticOrder S; S.init(T, DM, gridDim.x, (int)blockIdx.x);
        pg8::EpiResF32 E{args.out, args.in[0], DM};
        pg8::gemm_phase<pg8::EpiResF32, pg8::StaticOrder, true, true>(lds, g, S, E);
    }
#undef IN
#undef SEAM
}

extern "C" void kernel_launch(void* const* d_in, const int* in_sizes, int n_in, void* d_out, int out_size, void* d_ws, size_t ws_size, hipStream_t stream) {
    static int grid = 0;
    if (grid == 0) {
        if (n_in != 13 || ws_size < WS_END) { fprintf(stderr, "kernel_launch: unexpected inputs (n_in %d, ws %zu)\n", n_in, ws_size); grid = -1; return; }
        int dev = 0, cus = 0, per_cu = 0;
        (void)hipGetDevice(&dev); (void)hipDeviceGetAttribute(&cus, hipDeviceAttributeMultiprocessorCount, dev);
        if (hipFuncSetAttribute((const void*)hybrid_fwd, hipFuncAttributeMaxDynamicSharedMemorySize, LDS_BYTES) != hipSuccess) { fprintf(stderr, "kernel_launch: hipFuncSetAttribute failed\n"); grid = -1; return; }
        if (hipOccupancyMaxActiveBlocksPerMultiprocessor(&per_cu, (const void*)hybrid_fwd, NTHR, LDS_BYTES) != hipSuccess || per_cu < 1) { fprintf(stderr, "kernel_launch: occupancy query says %d blocks/CU\n", per_cu); per_cu = 1; }
        (void)hipGetLastError();
        grid = cus;
    }
    if (grid < 0) return;
    if (hipMemsetAsync((char*)d_ws + WS_BAR, 0, BAR_BYTES, stream) != hipSuccess) { fprintf(stderr, "kernel_launch: memset of barrier words failed\n"); return; }
    Args a{};
    for (int i = 0; i < 13; ++i) a.in[i] = (const float*)d_in[i];
    a.out = (float*)d_out; a.ws = (unsigned char*)d_ws;
#if MK_MULTI
    for (int p = 0; p < NPHASE; ++p) { a.ph_lo = p; a.ph_hi = p + 1; hipLaunchKernelGGL(hybrid_fwd, dim3(grid), dim3(NTHR), LDS_BYTES, stream, a); }
#else
    a.ph_lo = 0; a.ph_hi = NPHASE;
    void* kargs[] = {&a};
    hipError_t e = hipLaunchCooperativeKernel((const void*)hybrid_fwd, dim3(grid), dim3(NTHR), kargs, LDS_BYTES, stream);
    if (e != hipSuccess) fprintf(stderr, "cooperative launch failed: %s (grid %d)\n", hipGetErrorString(e), grid);
#endif
}
```

```cpp
#include <hip/hip_runtime.h>
#include <hip/hip_cooperative_groups.h>
#include <cstdio>
namespace cg = cooperative_groups;
namespace pg8 {
#define PG8_LAS __attribute__((address_space(3)))
typedef unsigned short bf16_t;
typedef short bf16x8 __attribute__((ext_vector_type(8)));
typedef float f32x4 __attribute__((ext_vector_type(4)));
typedef unsigned u32x4 __attribute__((ext_vector_type(4)));
constexpr int BM = 256, BK = 64, HALF = 128, HTB = HALF * BK * 2  , STAGE_BYTES = 8 * HTB, NXCD = 8, WGM = 8;

__host__ __device__ __forceinline__ int lds_byte(int r, int c) { const int st = (r >> 4) * 2 + (c >> 5), rr = r & 15, cc = c & 31, ob = rr * 64 + cc * 2; return st * 1024 + (ob ^ (((ob >> 9) & 1) << 5)); }
__host__ __device__ __forceinline__ void stage_rc(int b, int& R, int& C) { const int st = b / 1024, sb = b % 1024, swz = sb ^ (((sb >> 9) & 1) << 5); R = (st >> 1) * 16 + swz / 64; C = (st & 1) * 32 + (swz % 64) / 2; }
__host__ __device__ __forceinline__ int perm32(int rho) { const int n = rho >> 4, i = rho & 15; return 8 * (i >> 2) + 4 * n + (i & 3); }

struct Unit { int pm, pn; };
struct Gemm { const bf16_t* A; const bf16_t* Bt; int M, N, K; };

struct StaticOrder {
    int nM, nN, nwg, G, c;
    __host__ __device__ void init(int M, int N, int G_, int c_) { nM = M / BM; nN = N / BM; nwg = nM * nN; G = G_; c = c_; }
    __host__ __device__ bool next(int i, Unit& u) const {
        const long L = (long)i * G + c; if (L >= nwg) return false;
        int wgid = (int)L; { const int q = nwg / NXCD, r = nwg % NXCD, xcd = wgid % NXCD, off = wgid / NXCD; wgid = (xcd < r ? xcd * (q + 1) : r * (q + 1) + (xcd - r) * q) + off; }
        const int nig = WGM * nN, gid = wgid / nig, fm = gid * WGM, gsz = (nM - fm) < WGM ? (nM - fm) : WGM;
        u.pm = fm + ((wgid % nig) % gsz); u.pn = (wgid % nig) / gsz; return true;
    }
    __device__ __forceinline__ void a_ready(const Unit&) const {}
    __device__ __forceinline__ void done(const Unit&) const {}
};
typedef float f32x2 __attribute__((ext_vector_type(2)));
typedef __bf16 b16x2 __attribute__((ext_vector_type(2)));
typedef unsigned u32x2 __attribute__((ext_vector_type(2)));
__device__ __forceinline__ unsigned pk2(float lo, float hi) { f32x2 v = {lo, hi}; b16x2 b = __builtin_convertvector(v, b16x2); return __builtin_bit_cast(unsigned, b); }
__device__ __forceinline__ void st16_wt(void* p, u32x4 v) { asm volatile("global_store_dwordx4 %0, %1, off sc1\n\ts_nop 1" :: "v"(p), "v"(v) : "memory"); }
__device__ __forceinline__ void st8_wt(void* p, u32x2 v) { asm volatile("global_store_dwordx2 %0, %1, off sc1\n\ts_nop 1" :: "v"(p), "v"(v) : "memory"); }
struct EpiResF32 {
    static constexpr bool PERM = false, AFTER_DRAIN = false;
    float* C; const float* base; int ldc;
    __device__ __forceinline__ void operator()(const f32x4 (&acc)[2][2][4][2], const Unit& u, int wr, int wc, int fr, int fq) const {
        const int row0 = u.pm * BM + wr * 64 + fr, col0 = u.pn * BM + wc * 32 + 4 * fq;
#pragma unroll
        for (int ai = 0; ai < 2; ++ai) { f32x4 bs[4][2][2];
#pragma unroll
            for (int m = 0; m < 4; ++m) { const size_t off = (size_t)(row0 + ai * HALF + m * 16) * ldc + col0;
#pragma unroll
                for (int bj = 0; bj < 2; ++bj)
#pragma unroll
                    for (int n = 0; n < 2; ++n) bs[m][bj][n] = __builtin_nontemporal_load((const f32x4*)(base + off + bj * HALF + n * 16)); }
#pragma unroll
            for (int m = 0; m < 4; ++m) { const size_t off = (size_t)(row0 + ai * HALF + m * 16) * ldc + col0;
#pragma unroll
                for (int bj = 0; bj < 2; ++bj)
#pragma unroll
                    for (int n = 0; n < 2; ++n) *(f32x4*)(C + off + bj * HALF + n * 16) = acc[ai][bj][m][n] + bs[m][bj][n]; }
            asm volatile("" ::: "memory"); }
    }
};
struct EpiBf16Plain {
    static constexpr bool PERM = true, AFTER_DRAIN = false;
    bf16_t* O; int ldc;
    __device__ __forceinline__ void operator()(const f32x4 (&acc)[2][2][4][2], const Unit& u, int wr, int wc, int fr, int fq) const {
        const int row0 = u.pm * BM + wr * 64 + fr, col0 = u.pn * BM + wc * 32 + 8 * fq;
#pragma unroll
        for (int ai = 0; ai < 2; ++ai)
#pragma unroll
            for (int m = 0; m < 4; ++m) { bf16_t* rowp = O + (size_t)(row0 + ai * HALF + m * 16) * ldc + col0;
#pragma unroll
                for (int bj = 0; bj < 2; ++bj) { const f32x4 v0 = acc[ai][bj][m][0], v1 = acc[ai][bj][m][1];
                    u32x4 w; w.x = pk2(v0[0], v0[1]); w.y = pk2(v0[2], v0[3]); w.z = pk2(v1[0], v1[1]); w.w = pk2(v1[2], v1[3]);
                    *(u32x4*)(rowp + bj * HALF) = w; } }
    }
};
struct EpiVt {
    static constexpr bool PERM = true, AFTER_DRAIN = false;
    bf16_t* O;
    __device__ __forceinline__ void operator()(const f32x4 (&acc)[2][2][4][2], const Unit& u, int wr, int wc, int fr, int fq) const {
#pragma unroll
        for (int ai = 0; ai < 2; ++ai)
#pragma unroll
            for (int m = 0; m < 4; ++m) { const int dfull = u.pm * BM + ai * HALF + wr * 64 + m * 16 + fr;
#pragma unroll
                for (int bj = 0; bj < 2; ++bj) { const int tb = u.pn * 8 + bj * 4 + wc, hd = dfull >> 7, dt = (dfull >> 5) & 3, rr = dfull & 31;
                    bf16_t* p = O + ((size_t)(((tb >> 7) * 8 + hd) * 128 + (tb & 127))) * 4096 + (((dt * 2 + (fq >> 1)) * 2) * 32 + rr) * 8 + (fq & 1) * 4;
                    const f32x4 v0 = acc[ai][bj][m][0], v1 = acc[ai][bj][m][1];
                    u32x2 w0, w1; w0.x = pk2(v0[0], v0[1]); w0.y = pk2(v0[2], v0[3]); w1.x = pk2(v1[0], v1[1]); w1.y = pk2(v1[2], v1[3]);
                    *(u32x2*)p = w0; *(u32x2*)(p + 256) = w1; } }
    }
};
struct EpiInProj {
    static constexpr bool PERM = true, AFTER_DRAIN = false;
    bf16_t* out0; size_t seg_stride; const float* qg; const float* kg; PG8_LAS float* P; float qscale, eps;
    __device__ __forceinline__ void operator()(const f32x4 (&acc)[2][2][4][2], const Unit& u, int wr, int wc, int fr, int fq) const {
        const int seg = u.pn >> 2, colt = (u.pn & 3) * BM;
        bf16_t* O = out0 + (size_t)seg * seg_stride;
        const int row0 = u.pm * BM + wr * 64 + fr, col0 = colt + wc * 32 + 8 * fq;
        if (seg >= 2) {
#pragma unroll
            for (int ai = 0; ai < 2; ++ai)
#pragma unroll
                for (int m = 0; m < 4; ++m) { bf16_t* rowp = O + (size_t)(row0 + ai * HALF + m * 16) * 1024 + col0;
#pragma unroll
                    for (int bj = 0; bj < 2; ++bj) { const f32x4 v0 = acc[ai][bj][m][0], v1 = acc[ai][bj][m][1];
                        u32x4 w; w.x = pk2(v0[0], v0[1]); w.y = pk2(v0[2], v0[3]); w.z = pk2(v1[0], v1[1]); w.w = pk2(v1[2], v1[3]);
                        *(u32x4*)(rowp + bj * HALF) = w; } }
            return;
        }
#pragma unroll
        for (int ai = 0; ai < 2; ++ai)
#pragma unroll
            for (int m = 0; m < 4; ++m)
#pragma unroll
                for (int bj = 0; bj < 2; ++bj) { const f32x4 a = acc[ai][bj][m][0], b = acc[ai][bj][m][1];
                    float s = (a[0] * a[0] + a[1] * a[1]) + (a[2] * a[2] + a[3] * a[3]) + (b[0] * b[0] + b[1] * b[1]) + (b[2] * b[2] + b[3] * b[3]);
                    s += __shfl_xor(s, 16); s += __shfl_xor(s, 32);
                    if (fq == 0) P[(ai * HALF + wr * 64 + m * 16 + fr) * 8 + bj * 4 + wc] = s; }
        asm volatile("s_waitcnt lgkmcnt(0)" ::: "memory"); __builtin_amdgcn_s_barrier(); asm volatile("" ::: "memory");
        const float* gp = (seg == 0 ? qg : kg) + wc * 32 + 8 * fq;
        const f32x4 g0 = *(const f32x4*)gp, g1 = *(const f32x4*)(gp + 4);
        const float sc = seg == 0 ? qscale : 1.0f;
#pragma unroll
        for (int ai = 0; ai < 2; ++ai)
#pragma unroll
            for (int m = 0; m < 4; ++m) { const int tokrow = row0 + ai * HALF + m * 16, bb = tokrow >> 12, ss = tokrow & 4095;
#pragma unroll
                for (int bj = 0; bj < 2; ++bj) {
                    bf16_t* rowp = O + ((size_t)((bb * 8 + (u.pn & 3) * 2 + bj) * 128 + (ss >> 5))) * 4096 + (((2 * wc + (fq >> 1)) * 2 + (fq & 1)) * 32 + (ss & 31)) * 8 - bj * HALF;
                    const f32x4 p4 = *(const PG8_LAS f32x4*)(P + (ai * HALF + wr * 64 + m * 16 + fr) * 8 + bj * 4);
                    const float tot = (p4[0] + p4[1]) + (p4[2] + p4[3]);
                    const float rs = __builtin_amdgcn_rsqf(tot * (1.0f / 128.0f) + eps) * sc;
                    const f32x4 v0 = acc[ai][bj][m][0] * rs * g0, v1 = acc[ai][bj][m][1] * rs * g1;
                    u32x4 w; w.x = pk2(v0[0], v0[1]); w.y = pk2(v0[2], v0[3]); w.z = pk2(v1[0], v1[1]); w.w = pk2(v1[2], v1[3]);
                    *(u32x4*)(rowp + bj * HALF) = w; } }
    }
};
struct InProjOrder : StaticOrder {
    __host__ __device__ bool next(int i, Unit& u) const { if (!StaticOrder::next(i, u)) return false; if (u.pn >= 8) u.pn += 4; return true; }
};
template <class Epi, class Sched, bool ALIGN_EPI = false, bool SP2 = false>
__device__ __forceinline__ void gemm_phase(PG8_LAS unsigned char* lds, const Gemm g, const Sched& S, const Epi& E) {
    const int tid = threadIdx.x, wid = __builtin_amdgcn_readfirstlane(tid >> 6), lane = tid & 63, wr = wid >> 2, wc = wid & 3, fr = lane & 15, fq = lane >> 4;
    const int K = g.K, nt = K / BK;
    unsigned voffA[2], voffB[2];
#pragma unroll
    for (int i = 0; i < 2; ++i) { int R, C; stage_rc(tid * 16 + i * 8192, R, C); const int Rb = Epi::PERM ? ((R & ~31) + perm32(R & 31)) : R;
        voffA[i] = (unsigned)(R * K + C) * 2u; voffB[i] = (unsigned)(Rb * K + C) * 2u; }
    const size_t kstep = (size_t)(BK * 2);
    const size_t hstep = (size_t)HALF * K * 2;
    const size_t tstep = 2 * hstep;
    const unsigned ldsw = (unsigned)wid * 1024u;
    const int aoff = lds_byte(wr * 64 + fr, fq * 8), boff = lds_byte(wc * 32 + fr, fq * 8);
#define PG8_SA(b, h) (((b) * 2 + (h)) * HTB)
#define PG8_SB(b, h) ((4 + (b) * 2 + (h)) * HTB)
#define PG8_STAGE(bufoff, gbase, voff) do { _Pragma("unroll") for (int _i = 0; _i < 2; ++_i) \
        __builtin_amdgcn_global_load_lds((const unsigned*)((const char*)(gbase) + (voff)[_i]), (PG8_LAS unsigned*)(lds + (bufoff) + ldsw + _i * 8192), 16, 0, 0); } while (0)
#define PG8_LDA(dst, b, h) do { _Pragma("unroll") for (int m = 0; m < 4; ++m) _Pragma("unroll") for (int k = 0; k < 2; ++k) dst[m][k] = *(const PG8_LAS bf16x8*)(lds + PG8_SA(b, h) + aoff + m * 2048 + k * 1024); } while (0)
#define PG8_LDB(dst, b, h) do { _Pragma("unroll") for (int n = 0; n < 2; ++n) _Pragma("unroll") for (int k = 0; k < 2; ++k) dst[n][k] = *(const PG8_LAS bf16x8*)(lds + PG8_SB(b, h) + boff + n * 2048 + k * 1024); } while (0)
#define PG8_MMA(ai, bj, At, Bt) do { __builtin_amdgcn_s_setprio(1); _Pragma("unroll") for (int m = 0; m < 4; ++m) _Pragma("unroll") for (int n = 0; n < 2; ++n) _Pragma("unroll") for (int k = 0; k < 2; ++k) \
        acc[ai][bj][m][n] = __builtin_amdgcn_mfma_f32_16x16x32_bf16(Bt[n][k], At[m][k], acc[ai][bj][m][n], 0, 0, 0); __builtin_amdgcn_s_setprio(0); } while (0)
#define PG8_WAIT_V(n) asm volatile("s_waitcnt vmcnt(" #n ")" ::: "memory")
#define PG8_WAIT_L(n) asm volatile("s_waitcnt lgkmcnt(" #n ")" ::: "memory")
#define PG8_BAR __builtin_amdgcn_s_barrier()
#define PG8_SCHED __builtin_amdgcn_sched_barrier(0)
    Unit cur, nxt; int ui = 0;
    if (!S.next(0, cur)) return;
    f32x4 acc[2][2][4][2];
#pragma unroll
    for (int a = 0; a < 2; ++a)
#pragma unroll
        for (int b = 0; b < 2; ++b)
#pragma unroll
            for (int m = 0; m < 4; ++m)
#pragma unroll
                for (int n = 0; n < 2; ++n) acc[a][b][m][n] = (f32x4){0.f, 0.f, 0.f, 0.f};
    bf16x8 At[4][2], B0[2][2], B1[2][2];
    const char* cA = (const char*)g.A + (size_t)cur.pm * tstep; const char* cB = (const char*)g.Bt + (size_t)cur.pn * tstep;
    S.a_ready(cur);
    if constexpr (SP2) {
        PG8_STAGE(PG8_SB(0, 0), cB, voffB); PG8_STAGE(PG8_SB(0, 1), cB + hstep, voffB); PG8_STAGE(PG8_SA(0, 0), cA, voffA); PG8_STAGE(PG8_SA(0, 1), cA + hstep, voffA);
        if (wr == 1) PG8_BAR;
        PG8_WAIT_V(2); PG8_BAR;
        PG8_STAGE(PG8_SB(1, 0), cB + kstep, voffB); PG8_STAGE(PG8_SA(1, 0), cA + kstep, voffA); PG8_STAGE(PG8_SB(1, 1), cB + hstep + kstep, voffB);
        PG8_WAIT_V(6); PG8_BAR;
    } else {
        PG8_STAGE(PG8_SB(0, 0), cB, voffB); PG8_STAGE(PG8_SA(0, 0), cA, voffA); PG8_STAGE(PG8_SB(0, 1), cB + hstep, voffB); PG8_STAGE(PG8_SA(0, 1), cA + hstep, voffA);
        if (wr == 1) PG8_BAR;
        PG8_WAIT_V(4); PG8_BAR;
        PG8_STAGE(PG8_SB(1, 0), cB + kstep, voffB); PG8_STAGE(PG8_SA(1, 0), cA + kstep, voffA); PG8_STAGE(PG8_SB(1, 1), cB + hstep + kstep, voffB);
        PG8_WAIT_V(6); PG8_BAR;
    }
    for (;;) {
        const bool has_next = S.next(ui + 1, nxt);
        const char* nA = has_next ? (const char*)g.A + (size_t)nxt.pm * tstep : cA; const char* nB = has_next ? (const char*)g.Bt + (size_t)nxt.pn * tstep : cB;
        for (int t = 0; t < nt; t += 2) {
            const bool last = (t == nt - 2);
            const char* a1 = cA + (size_t)(t + 1) * kstep;
            const char* a2 = last ? nA : cA + (size_t)(t + 2) * kstep; const char* b2 = last ? nB : cB + (size_t)(t + 2) * kstep;
            const char* a3 = a2 + kstep; const char* b3 = b2 + kstep;
            if (last && has_next) S.a_ready(nxt);
            if constexpr (SP2) {
            PG8_LDB(B0, 0, 0); PG8_LDB(B1, 0, 1); PG8_SCHED; PG8_LDA(At, 0, 0); PG8_STAGE(PG8_SA(1, 1), a1 + hstep, voffA);
            PG8_WAIT_V(8); PG8_WAIT_L(0); PG8_BAR; PG8_MMA(0, 0, At, B0); PG8_MMA(0, 1, At, B1); PG8_BAR; PG8_SCHED;
            PG8_LDA(At, 0, 1); PG8_STAGE(PG8_SB(0, 0), b2, voffB); PG8_STAGE(PG8_SB(0, 1), b2 + hstep, voffB); PG8_STAGE(PG8_SA(0, 0), a2, voffA);
            PG8_WAIT_V(8); PG8_WAIT_L(0); PG8_BAR; PG8_MMA(1, 0, At, B0); PG8_MMA(1, 1, At, B1); PG8_BAR; PG8_SCHED;
            PG8_LDB(B0, 1, 0); PG8_LDB(B1, 1, 1); PG8_SCHED; PG8_LDA(At, 1, 0); PG8_STAGE(PG8_SA(0, 1), a2 + hstep, voffA);
            PG8_WAIT_V(8); PG8_WAIT_L(0); PG8_BAR; PG8_MMA(0, 0, At, B0); PG8_MMA(0, 1, At, B1); PG8_BAR; PG8_SCHED;
            PG8_LDA(At, 1, 1); PG8_STAGE(PG8_SB(1, 0), b3, voffB); PG8_STAGE(PG8_SB(1, 1), b3 + hstep, voffB); PG8_STAGE(PG8_SA(1, 0), a3, voffA);
            PG8_WAIT_V(8); PG8_WAIT_L(0); PG8_BAR; PG8_MMA(1, 0, At, B0); PG8_MMA(1, 1, At, B1); PG8_BAR; PG8_SCHED;
            } else {
            PG8_LDB(B0, 0, 0); PG8_SCHED; PG8_LDA(At, 0, 0); PG8_STAGE(PG8_SA(1, 1), a1 + hstep, voffA);
            PG8_WAIT_L(8); PG8_BAR; PG8_WAIT_L(0); PG8_MMA(0, 0, At, B0); PG8_BAR; PG8_SCHED;
            PG8_LDB(B1, 0, 1); PG8_STAGE(PG8_SB(0, 0), b2, voffB);
            PG8_BAR; PG8_WAIT_L(0); PG8_MMA(0, 1, At, B1); PG8_BAR;
            PG8_LDA(At, 0, 1); PG8_STAGE(PG8_SA(0, 0), a2, voffA);
            PG8_BAR; PG8_WAIT_L(0); PG8_MMA(1, 0, At, B0); PG8_BAR; PG8_SCHED;
            PG8_STAGE(PG8_SB(0, 1), b2 + hstep, voffB);
            PG8_WAIT_V(6); PG8_BAR; PG8_MMA(1, 1, At, B1); PG8_BAR;
            PG8_LDB(B0, 1, 0); PG8_SCHED; PG8_LDA(At, 1, 0); PG8_STAGE(PG8_SA(0, 1), a2 + hstep, voffA);
            PG8_WAIT_L(8); PG8_BAR; PG8_WAIT_L(0); PG8_MMA(0, 0, At, B0); PG8_BAR; PG8_SCHED;
            PG8_LDB(B1, 1, 1); PG8_STAGE(PG8_SB(1, 0), b3, voffB);
            PG8_BAR; PG8_WAIT_L(0); PG8_MMA(0, 1, At, B1); PG8_BAR;
            PG8_LDA(At, 1, 1); PG8_STAGE(PG8_SA(1, 0), a3, voffA);
            PG8_BAR; PG8_WAIT_L(0); PG8_MMA(1, 0, At, B0); PG8_BAR; PG8_SCHED;
            PG8_STAGE(PG8_SB(1, 1), b3 + hstep, voffB);
            PG8_WAIT_V(6); PG8_BAR; PG8_MMA(1, 1, At, B1); PG8_BAR;
            }
        }
        if constexpr (ALIGN_EPI) { if (wr == 0) PG8_BAR; }
        if constexpr (!Epi::AFTER_DRAIN) { E(acc, cur, wr, wc, fr, fq); S.done(cur); }
        if (!has_next) break;
#pragma unroll
        for (int a = 0; a < 2; ++a)
#pragma unroll
            for (int b = 0; b < 2; ++b)
#pragma unroll
                for (int m = 0; m < 4; ++m)
#pragma unroll
                    for (int n = 0; n < 2; ++n) acc[a][b][m][n] = (f32x4){0.f, 0.f, 0.f, 0.f};
        cur = nxt; cA = nA; cB = nB; ++ui;
        if constexpr (ALIGN_EPI) { if (wr == 1) PG8_BAR; }
    }
    PG8_WAIT_V(0);
    if constexpr (!ALIGN_EPI) { if (wr == 0) PG8_BAR; }
    PG8_BAR;
    if constexpr (Epi::AFTER_DRAIN) { E.fused(acc, cur, wr, wc, fr, fq, lds, wid, lane); S.done(cur); }
#undef PG8_SA
#undef PG8_SB
#undef PG8_STAGE
#undef PG8_LDA
#undef PG8_LDB
#undef PG8_MMA
#undef PG8_WAIT_V
#undef PG8_WAIT_L
#undef PG8_BAR
#undef PG8_SCHED
}
}
#define GAS __attribute__((address_space(1)))
#define LAS __attribute__((address_space(3)))
typedef unsigned short bf16;
typedef unsigned v4u __attribute__((ext_vector_type(4)));
typedef unsigned v2u __attribute__((ext_vector_type(2)));
typedef float f32x4 __attribute__((ext_vector_type(4)));
typedef float f32x16 __attribute__((ext_vector_type(16)));
typedef short bf16x8 __attribute__((ext_vector_type(8)));
typedef short s16x4 __attribute__((ext_vector_type(4)));
using pg8::pk2;
constexpr int NWAVES = 8, NTHR = 512;
constexpr int DM = 2048, BATCH = 4, SEQ = 4096, T = BATCH * SEQ, DIN = 6144, W = 1024, NH = 8, HD = 128, NG = 8, GD = 128;
constexpr int LCH = 64, NCH = SEQ / LCH;
constexpr float EPS = 1e-6f, LOG2E = 1.4426950408889634f, LN2 = 0.6931471805599453f;
constexpr float QSCALE = 0.08838834764831845f * LOG2E;
constexpr size_t MiB = 1u << 20;
constexpr size_t WS_WIN = 0, WS_WOUT = 24 * MiB, WS_WA = 32 * MiB, WS_WX = WS_WA + 256 * 1024, WS_AAGG = 33 * MiB, WS_HAGG = 34 * MiB;
constexpr size_t WS_BAR = 35 * MiB, BAR_BYTES = 16384;
constexpr size_t WS_XN = 36 * MiB, WS_Q = 100 * MiB, WS_K = 132 * MiB, WS_VT = 164 * MiB, WS_GSB = 196 * MiB, WS_XL = 228 * MiB, WS_GL = 260 * MiB;
constexpr size_t WS_HL = 292 * MiB, WS_PC = 324 * MiB, WS_Y = 356 * MiB, WS_END = 420 * MiB;
constexpr int RING_BYTES = 131072, PTAB_OFF = RING_BYTES, MISC_OFF = PTAB_OFF + 8192, LDS_BYTES = 147456;
static_assert(8 * 16896 <= MISC_OFF, "attention epilogue slices stay below the barrier's LDS words");

#define LDS_WAIT() asm volatile("s_waitcnt lgkmcnt(0)" ::: "memory")
__device__ __forceinline__ float bf2f(unsigned short b) { return __builtin_bit_cast(float, (unsigned)b << 16); }
__device__ __forceinline__ float bflo(unsigned w) { return __builtin_bit_cast(float, w << 16); }
__device__ __forceinline__ float bfhi(unsigned w) { return __builtin_bit_cast(float, w & 0xffff0000u); }
__device__ __forceinline__ float wave_sum(float v) {
#pragma unroll
    for (int o = 1; o < 64; o <<= 1) v += __shfl_xor(v, o);
    return v;
}
__device__ __forceinline__ float sigmoidf_(float x) { return __builtin_amdgcn_rcpf(1.0f + __builtin_amdgcn_exp2f(-x * LOG2E)); }
__device__ __forceinline__ float siluf_(float x) { return x * sigmoidf_(x); }

struct Args { const float* in[13]; float* out; unsigned char* ws; int ph_lo, ph_hi; };

__device__ __forceinline__ void p0_transpose_item(const float* Wm, int K, int N, bf16* WT, LAS float* scr, int item, int lane) {
    const int nblk = N / 32, kb = item / nblk, nb = item % nblk, k0 = 64 * kb, n0 = 32 * nb;
#pragma unroll 8
    for (int i = 0; i < 32; ++i) { const int kk = 2 * i + (lane >> 5); scr[kk * 33 + (lane & 31)] = __builtin_nontemporal_load(Wm + (size_t)(k0 + kk) * N + n0 + (lane & 31)); }
    LDS_WAIT(); asm volatile("" ::: "memory");
    const int c = lane & 7;
#pragma unroll
    for (int j = 0; j < 4; ++j) { const int n = (lane >> 3) + 8 * j; const LAS float* s = scr + (8 * c) * 33 + n;
        v4u o; o.x = pk2(s[0 * 33], s[1 * 33]); o.y = pk2(s[2 * 33], s[3 * 33]); o.z = pk2(s[4 * 33], s[5 * 33]); o.w = pk2(s[6 * 33], s[7 * 33]);
        pg8::st16_wt(WT + (size_t)(n0 + n) * K + k0 + 8 * c, o); }
    LDS_WAIT(); asm volatile("" ::: "memory");
}
__device__ __forceinline__ void p0_prep(const Args& a, LAS unsigned char* lds, int wave, int lane) {
    LAS float* scr = (LAS float*)(lds + wave * 16384);
    const int gw = blockIdx.x * NWAVES + wave, NGW = gridDim.x * NWAVES;
    unsigned char* ws = a.ws;
    constexpr int I_IN = (DM / 64) * (DIN / 32), I_OUT = (W * 2 / 64) * (DM / 32), I_G = (GD / 64) * (GD / 32);
    constexpr int NITEMS = I_IN + I_OUT + 2 * NG * I_G;
    for (int it = gw; it < NITEMS; it += NGW) {
        int r = it;
        if (r < I_IN) { p0_transpose_item(a.in[2], DM, DIN, (bf16*)(ws + WS_WIN), scr, r, lane); continue; } r -= I_IN;
        if (r < I_OUT) { p0_transpose_item(a.in[12], 2 * W, DM, (bf16*)(ws + WS_WOUT), scr, r, lane); continue; } r -= I_OUT;
        if (r < NG * I_G) { const int g = r / I_G; p0_transpose_item(a.in[7] + g * GD * GD, GD, GD, (bf16*)(ws + WS_WA) + g * GD * GD, scr, r % I_G, lane); continue; } r -= NG * I_G;
        { const int g = r / I_G; p0_transpose_item(a.in[9] + g * GD * GD, GD, GD, (bf16*)(ws + WS_WX) + g * GD * GD, scr, r % I_G, lane); }
    }
    const float* x = a.in[0]; const float* gain = a.in[1]; bf16* XN = (bf16*)(ws + WS_XN);
    f32x4 gv[8];
#pragma unroll
    for (int j = 0; j < 8; ++j) gv[j] = *((const f32x4*)gain + 64 * j + lane);
    for (int m = gw; m < T; m += NGW) {
        const f32x4* xr = (const f32x4*)(x + (size_t)m * DM) + lane;
        f32x4 v[8]; float s = 0.f;
#pragma unroll
        for (int j = 0; j < 8; ++j) { v[j] = __builtin_nontemporal_load(xr + 64 * j); s += (v[j].x * v[j].x + v[j].y * v[j].y) + (v[j].z * v[j].z + v[j].w * v[j].w); }
        const float rstd = __builtin_amdgcn_rsqf(wave_sum(s) * (1.f / DM) + EPS);
        v2u* o8 = (v2u*)(XN + (size_t)m * DM) + lane;
#pragma unroll
        for (int j = 0; j < 8; ++j) { const f32x4 y = v[j] * rstd * gv[j]; v2u o; o.x = pk2(y.x, y.y); o.y = pk2(y.z, y.w); pg8::st8_wt(o8 + 64 * j, o); }
    }
}

__device__ __forceinline__ int crow(int reg, int h) { return (reg & 3) + 8 * (reg >> 2) + 4 * h; }
template <bool DIAG>
__device__ __forceinline__ void sb_tile(const f32x16& sc, float& carry, int r, int h, bf16x8 (&pf)[2]) {
    typedef float f2 __attribute__((ext_vector_type(2)));
    f2 m[2][4];
#pragma unroll
    for (int gp = 0; gp < 2; ++gp)
#pragma unroll
        for (int j = 0; j < 4; ++j) { f2 e; e.x = __builtin_amdgcn_exp2f(sc[8 * gp + j]); e.y = __builtin_amdgcn_exp2f(sc[8 * gp + 4 + j]);
            const f2 t = e + 1.0f; f2 v; v.x = __builtin_amdgcn_rcpf(t.x); v.y = __builtin_amdgcn_rcpf(t.y);
            if (DIAG) { if (crow(8 * gp + j, h) >= r) v.x = 1.0f; if (crow(8 * gp + 4 + j, h) >= r) v.y = 1.0f; }
            m[gp][j] = v; }
#pragma unroll
    for (int gp = 0; gp < 2; ++gp) { m[gp][2] *= m[gp][3]; m[gp][1] *= m[gp][2]; m[gp][0] *= m[gp][1]; }
    float tg[4] = {m[0][0].x, m[0][0].y, m[1][0].x, m[1][0].y}, og[4], base[4];
#pragma unroll
    for (int g = 0; g < 4; ++g) { const unsigned tu = __builtin_bit_cast(unsigned, tg[g]); const auto sw = __builtin_amdgcn_permlane32_swap(tu, tu, false, false);
        og[g] = __builtin_bit_cast(float, h == 0 ? sw[1] : sw[0]); }
    float later = carry;
#pragma unroll
    for (int g = 3; g >= 0; --g) { base[g] = h == 0 ? later * og[g] : later; later *= tg[g] * og[g]; }
    carry = later;
    f2 p[2][4];
#pragma unroll
    for (int gp = 0; gp < 2; ++gp) { const f2 bs = {base[2 * gp], base[2 * gp + 1]};
        p[gp][3] = bs * (1.0f - m[gp][3]); p[gp][2] = bs * (m[gp][3] - m[gp][2]); p[gp][1] = bs * (m[gp][2] - m[gp][1]); p[gp][0] = bs * (m[gp][1] - m[gp][0]); }
#pragma unroll
    for (int s = 0; s < 2; ++s) { v4u q; q.x = pk2(p[s][0].x, p[s][1].x); q.y = pk2(p[s][2].x, p[s][3].x); q.z = pk2(p[s][0].y, p[s][1].y); q.w = pk2(p[s][2].y, p[s][3].y); pf[s] = __builtin_bit_cast(bf16x8, q); }
}
__device__ __forceinline__ void attn_tile(const bf16* Qf, const bf16* Kf, const bf16* Vf, const bf16* Gsb, bf16* Y, LAS float* ol, int b, int hd, int qt, int lane) {
    const int r = lane & 31, h = lane >> 5;
    const size_t tok0 = (size_t)b * SEQ;
    const size_t hb = (size_t)(b * NH + hd) * (SEQ / 32) * 4096;
    const bf16* kbase = Kf + hb + lane * 8;
    const bf16* vbase = Vf + hb + lane * 8;
    bf16x8 qf[8], kf[8];
#pragma unroll
    for (int ks = 0; ks < 8; ++ks) qf[ks] = *(const bf16x8*)(Qf + hb + (size_t)qt * 4096 + lane * 8 + ks * 512);
#pragma unroll
    for (int ks = 0; ks < 8; ++ks) kf[ks] = *(const bf16x8*)(kbase + (size_t)qt * 4096 + ks * 512);
    f32x16 o[4];
#pragma unroll
    for (int dt = 0; dt < 4; ++dt)
#pragma unroll
        for (int i = 0; i < 16; ++i) o[dt][i] = 0.f;
    float carry = 1.0f;
    f32x16 sa, sb;
#pragma unroll
    for (int i = 0; i < 16; ++i) sa[i] = 0.f;
#pragma unroll
    for (int ks = 0; ks < 8; ++ks) sa = __builtin_amdgcn_mfma_f32_32x32x16_bf16(kf[ks], qf[ks], sa, 0, 0, 0);
    { const int kn = qt > 0 ? qt - 1 : 0;
#pragma unroll
      for (int ks = 0; ks < 8; ++ks) kf[ks] = *(const bf16x8*)(kbase + (size_t)kn * 4096 + ks * 512); }
#define ATT_ITER(SCUR, SNXT) { \
        bf16x8 vf[4][2]; \
        _Pragma("unroll") for (int dt = 0; dt < 4; ++dt) _Pragma("unroll") for (int s = 0; s < 2; ++s) vf[dt][s] = *(const bf16x8*)(vbase + (size_t)kt * 4096 + (dt * 2 + s) * 512); \
        _Pragma("unroll") for (int i = 0; i < 16; ++i) SNXT[i] = 0.f; \
        _Pragma("unroll") for (int ks = 0; ks < 8; ++ks) SNXT = __builtin_amdgcn_mfma_f32_32x32x16_bf16(kf[ks], qf[ks], SNXT, 0, 0, 0);     \
        { const int kn = kt > 1 ? kt - 2 : 0; \
          _Pragma("unroll") for (int ks = 0; ks < 8; ++ks) kf[ks] = *(const bf16x8*)(kbase + (size_t)kn * 4096 + ks * 512); } \
        bf16x8 pf[2]; \
        if (kt == qt) sb_tile<true>(SCUR, carry, r, h, pf); else sb_tile<false>(SCUR, carry, r, h, pf); \
        _Pragma("unroll") for (int dt = 0; dt < 4; ++dt) _Pragma("unroll") for (int s = 0; s < 2; ++s) o[dt] = __builtin_amdgcn_mfma_f32_32x32x16_bf16(vf[dt][s], pf[s], o[dt], 0, 0, 0); \
        if (__all(carry == 0.0f)) break; \
        if (--kt < 0) break; }
    for (int kt = qt; ; ) {
        ATT_ITER(sa, sb)
        ATT_ITER(sb, sa)
    }
#undef ATT_ITER
#pragma unroll
    for (int dt = 0; dt < 4; ++dt)
#pragma unroll
        for (int g = 0; g < 4; ++g) *(LAS f32x4*)(ol + r * 132 + 32 * dt + 8 * g + 4 * h) = (f32x4){o[dt][4 * g], o[dt][4 * g + 1], o[dt][4 * g + 2], o[dt][4 * g + 3]};
    { const int rw = lane >> 4, ch = lane & 15;
      const size_t tokb = tok0 + qt * 32;
      v4u gv[8];
#pragma unroll
      for (int ps = 0; ps < 8; ++ps) gv[ps] = *(const v4u*)(Gsb + (tokb + 4 * ps + rw) * W + hd * HD + 8 * ch);
#pragma unroll
      for (int ps = 0; ps < 8; ++ps) { const LAS float* op = ol + (4 * ps + rw) * 132 + 8 * ch;
          const f32x4 o0 = *(const LAS f32x4*)op, o1 = *(const LAS f32x4*)(op + 4);
          const v4u gw = gv[ps]; v4u ov;
          ov.x = pk2(o0[0] * siluf_(bflo(gw.x)), o0[1] * siluf_(bfhi(gw.x))); ov.y = pk2(o0[2] * siluf_(bflo(gw.y)), o0[3] * siluf_(bfhi(gw.y)));
          ov.z = pk2(o1[0] * siluf_(bflo(gw.z)), o1[1] * siluf_(bfhi(gw.z))); ov.w = pk2(o1[2] * siluf_(bflo(gw.w)), o1[3] * siluf_(bfhi(gw.w)));
          *(v4u*)(Y + (tokb + 4 * ps + rw) * (2 * W) + hd * HD + 8 * ch) = ov; } }
}
__device__ __forceinline__ void p2_attention(const Args& a, LAS unsigned char* lds, int wave, int lane) {
    unsigned char* ws = a.ws;
    const bf16 *Qb = (const bf16*)(ws + WS_Q), *Kb = (const bf16*)(ws + WS_K), *Vt = (const bf16*)(ws + WS_VT), *Gsb = (const bf16*)(ws + WS_GSB); bf16* Y = (bf16*)(ws + WS_Y);
    const int gw = blockIdx.x * NWAVES + wave, NGW = gridDim.x * NWAVES;
    constexpr int NQT = SEQ / 32, NIT = BATCH * NH * NQT;
    for (int it = gw; it < NIT; it += NGW) {
        const int qt = it % NQT, bh = it / NQT;
        attn_tile(Qb, Kb, Vt, Gsb, Y, (LAS float*)(lds + wave * 16896), bh / NH, bh % NH, qt, lane);
    }
}

constexpr int XCB_STRIDE = 136;
constexpr int L_XCB = 0, L_XCF = 20480, L_A = L_XCF + 64 * 128 * 4, L_U = L_A + 64 * 128 * 4, L_SEG = L_U + 64 * 128 * 4;
static_assert(L_SEG + 2 * 8 * 128 * 4 <= RING_BYTES && 64 * XCB_STRIDE * 2 <= L_XCF, "lru lds map");
__device__ __forceinline__ float one_minus_exp(float x, float ex) {
    const float p = -x * (1.0f + x * 0.5f * (1.0f + x * (1.0f / 3.0f) * (1.0f + x * 0.25f * (1.0f + x * 0.2f * (1.0f + x * (1.0f / 6.0f))))));
    return x > -0.3f ? p : 1.0f - ex;
}
constexpr int L_CW = L_SEG + 2 * 8 * 128 * 4;
static_assert(L_CW + 5 * 128 * 4 <= RING_BYTES, "lru lds map (conv weights)");
__device__ __forceinline__ void p2_lru(const Args& a, LAS unsigned char* lds, int tid, int wave, int lane) {
    unsigned char* ws = a.ws;
    const bf16* XL = (const bf16*)(ws + WS_XL);
    LAS bf16* xcb = (LAS bf16*)(lds + L_XCB); LAS float* xcf = (LAS float*)(lds + L_XCF); LAS float* aS = (LAS float*)(lds + L_A); LAS float* uS = (LAS float*)(lds + L_U); LAS float* seg = (LAS float*)(lds + L_SEG);
    LAS float* cw = (LAS float*)(lds + L_CW);
    const float* conv_w = a.in[5]; const float* conv_b = a.in[6];
    const int mt = wave >> 2, nt = wave & 3, r = lane & 31, h = lane >> 5, cl = 32 * nt + r;
    const int tr = tid >> 3, cc = tid & 7;
    constexpr int NITEM = BATCH * NCH * NG;
    int gcur = -1; bf16x8 wfa[8], wfx[8]; float ba_ = 0.f, bx_ = 0.f, sp8 = 0.f;
    v4u xr[2][4];
#define LRU_LOAD_ROWS(ITEM) { const int g_ = (ITEM) % NG, ch_ = ((ITEM) / NG) % NCH, b_ = (ITEM) / (NG * NCH); const size_t t0_ = (size_t)b_ * SEQ + ch_ * LCH; \
        _Pragma("unroll") for (int hh = 0; hh < 2; ++hh) _Pragma("unroll") for (int i = 0; i < 4; ++i) { int dr = tr + i - 3; if (ch_ * LCH + dr < 0) dr = 0; \
            xr[hh][i] = *(const v4u*)(XL + (t0_ + dr) * W + g_ * GD + cc * 16 + hh * 8); } }
    if ((int)blockIdx.x < NITEM) LRU_LOAD_ROWS((int)blockIdx.x)
    for (int item = blockIdx.x; item < NITEM; item += gridDim.x) {
        const int g = item % NG, ch = (item / NG) % NCH, b = item / (NG * NCH);
        const size_t t0 = (size_t)b * SEQ + ch * LCH;
        if (g != gcur) {
            gcur = g;
            const bf16* wa = (const bf16*)(ws + WS_WA) + (size_t)g * GD * GD + cl * GD + 8 * h;
            const bf16* wx = (const bf16*)(ws + WS_WX) + (size_t)g * GD * GD + cl * GD + 8 * h;
#pragma unroll
            for (int ks = 0; ks < 8; ++ks) { wfa[ks] = *(const bf16x8*)(wa + 16 * ks); wfx[ks] = *(const bf16x8*)(wx + 16 * ks); }
            const int cgl = g * GD + cl;
            ba_ = a.in[8][cgl]; bx_ = a.in[10][cgl];
            const float nl = -a.in[11][cgl]; sp8 = -8.0f * (fmaxf(nl, 0.f) + log1pf(__expf(-fabsf(nl))));
            __syncthreads();
            if (tid < 128) {
#pragma unroll
                for (int i = 0; i < 4; ++i) cw[i * 128 + tid] = conv_w[i * W + g * GD + tid];
                cw[512 + tid] = conv_b[g * GD + tid]; }
            __syncthreads();
        }
#pragma unroll
        for (int hh = 0; hh < 2; ++hh) { const int c0 = cc * 16 + hh * 8;
            float accv[8];
            { const f32x4 b0 = *(const LAS f32x4*)(cw + 512 + c0), b1 = *(const LAS f32x4*)(cw + 512 + c0 + 4);
              accv[0] = b0[0]; accv[1] = b0[1]; accv[2] = b0[2]; accv[3] = b0[3]; accv[4] = b1[0]; accv[5] = b1[1]; accv[6] = b1[2]; accv[7] = b1[3]; }
#pragma unroll
            for (int i = 0; i < 4; ++i) { const float mk = (ch * LCH + tr + i - 3 >= 0) ? 1.0f : 0.0f;
                const v4u xv = xr[hh][i];
                const f32x4 w0 = *(const LAS f32x4*)(cw + i * 128 + c0) * mk, w1 = *(const LAS f32x4*)(cw + i * 128 + c0 + 4) * mk;
                accv[0] += bflo(xv.x) * w0[0]; accv[1] += bfhi(xv.x) * w0[1]; accv[2] += bflo(xv.y) * w0[2]; accv[3] += bfhi(xv.y) * w0[3];
                accv[4] += bflo(xv.z) * w1[0]; accv[5] += bfhi(xv.z) * w1[1]; accv[6] += bflo(xv.w) * w1[2]; accv[7] += bfhi(xv.w) * w1[3]; }
            v4u pb; pb.x = pk2(accv[0], accv[1]); pb.y = pk2(accv[2], accv[3]); pb.z = pk2(accv[4], accv[5]); pb.w = pk2(accv[6], accv[7]);
            *(LAS v4u*)(xcb + tr * XCB_STRIDE + c0) = pb;
            *(LAS f32x4*)(xcf + tr * 128 + c0) = (f32x4){accv[0], accv[1], accv[2], accv[3]}; *(LAS f32x4*)(xcf + tr * 128 + c0 + 4) = (f32x4){accv[4], accv[5], accv[6], accv[7]}; }
        __syncthreads();
        { const int nx = item + (int)gridDim.x < NITEM ? item + (int)gridDim.x : item;
          LRU_LOAD_ROWS(nx) }
        { f32x16 R, I;
#pragma unroll
          for (int i = 0; i < 16; ++i) { R[i] = 0.f; I[i] = 0.f; }
#pragma unroll
          for (int ks = 0; ks < 8; ++ks) { const bf16x8 af = *(const LAS bf16x8*)(xcb + (32 * mt + r) * XCB_STRIDE + 16 * ks + 8 * h);
              R = __builtin_amdgcn_mfma_f32_32x32x16_bf16(af, wfa[ks], R, 0, 0, 0); I = __builtin_amdgcn_mfma_f32_32x32x16_bf16(af, wfx[ks], I, 0, 0, 0); }
#pragma unroll
          for (int i = 0; i < 16; i += 2) {
              typedef float f2 __attribute__((ext_vector_type(2)));
              const int tk = 32 * mt + crow(i, h);
              const f2 zr = (f2){R[i], R[i + 1]} + ba_, zi = (f2){I[i], I[i + 1]} + bx_;
              const f2 ar = zr * (-LOG2E), ai = zi * (-LOG2E);
              f2 er, ei; er.x = __builtin_amdgcn_exp2f(ar.x); er.y = __builtin_amdgcn_exp2f(ar.y); ei.x = __builtin_amdgcn_exp2f(ai.x); ei.y = __builtin_amdgcn_exp2f(ai.y);
              const f2 tr2 = er + 1.0f, ti2 = ei + 1.0f;
              f2 rr, ii; rr.x = __builtin_amdgcn_rcpf(tr2.x); rr.y = __builtin_amdgcn_rcpf(tr2.y); ii.x = __builtin_amdgcn_rcpf(ti2.x); ii.y = __builtin_amdgcn_rcpf(ti2.y);
              const f2 log_a = rr * sp8, la2 = log_a * LOG2E;
              f2 av; av.x = __builtin_amdgcn_exp2f(la2.x); av.y = __builtin_amdgcn_exp2f(la2.y);
              const f2 x = log_a * 2.0f;
              const f2 pl = -x * (1.0f + x * 0.5f * (1.0f + x * (1.0f / 3.0f) * (1.0f + x * 0.25f * (1.0f + x * 0.2f * (1.0f + x * (1.0f / 6.0f))))));
              const f2 big = 1.0f - av * av;
              f2 om; om.x = x.x > -0.3f ? pl.x : big.x; om.y = x.y > -0.3f ? pl.y : big.y;
              f2 sq; sq.x = __builtin_amdgcn_sqrtf(om.x); sq.y = __builtin_amdgcn_sqrtf(om.y);
              const f2 xc2 = {xcf[tk * 128 + cl], xcf[(tk + 1) * 128 + cl]};
              const f2 uv = sq * (ii * xc2);
              aS[tk * 128 + cl] = av.x; aS[(tk + 1) * 128 + cl] = av.y; uS[tk * 128 + cl] = uv.x; uS[(tk + 1) * 128 + cl] = uv.y; } }
        __syncthreads();
        { const int cp = tid & 63, sg = tid >> 6;
          typedef float f32x2 __attribute__((ext_vector_type(2)));
          f32x2 hl[8], pl[8]; f32x2 H = {0.f, 0.f}, Pc = {1.f, 1.f};
#pragma unroll
          for (int k = 0; k < 8; ++k) { const f32x2 av = *(const LAS f32x2*)(aS + (8 * sg + k) * 128 + 2 * cp), uv = *(const LAS f32x2*)(uS + (8 * sg + k) * 128 + 2 * cp); H = av * H + uv; Pc *= av; hl[k] = H; pl[k] = Pc; }
          *(LAS f32x2*)(seg + sg * 128 + 2 * cp) = Pc; *(LAS f32x2*)(seg + 1024 + sg * 128 + 2 * cp) = H;
          __syncthreads();
          f32x2 Hin = {0.f, 0.f}, Ain = {1.f, 1.f};
#pragma unroll
          for (int q = 0; q < 7; ++q) if (q < sg) { const f32x2 sa = *(const LAS f32x2*)(seg + q * 128 + 2 * cp), sh = *(const LAS f32x2*)(seg + 1024 + q * 128 + 2 * cp); Hin = sa * Hin + sh; Ain *= sa; }
          unsigned* HL = (unsigned*)((bf16*)(ws + WS_HL) + (t0 + 8 * sg) * W + g * GD + 2 * cp); unsigned* PC = (unsigned*)((bf16*)(ws + WS_PC) + (t0 + 8 * sg) * W + g * GD + 2 * cp);
          f32x2 hlast = {0.f, 0.f}, plast = {0.f, 0.f};
#pragma unroll
          for (int k = 0; k < 8; ++k) { const f32x2 hv = hl[k] + pl[k] * Hin, pv = pl[k] * Ain; hlast = hv; plast = pv;
              HL[(size_t)k * (W / 2)] = pk2(hv.x, hv.y); PC[(size_t)k * (W / 2)] = pk2(pv.x, pv.y); }
          if (sg == 7) { *(f32x2*)((float*)(ws + WS_AAGG) + ((size_t)b * NCH + ch) * W + g * GD + 2 * cp) = plast; *(f32x2*)((float*)(ws + WS_HAGG) + ((size_t)b * NCH + ch) * W + g * GD + 2 * cp) = hlast; } }
        __syncthreads();
    }
#undef LRU_LOAD_ROWS
}

__device__ __forceinline__ void p3_item(const Args& a, LAS unsigned char* lds, int item, int tid) {
    unsigned char* ws = a.ws;
    const int o8 = item % 8, g = (item / 8) % NG, b = item / (8 * NG);
    LAS float* hin = (LAS float*)lds;
    const float* AA = (const float*)(ws + WS_AAGG) + (size_t)b * NCH * W + g * GD; const float* HA = (const float*)(ws + WS_HAGG) + (size_t)b * NCH * W + g * GD;
    const int c8 = (tid & 15) * 8, row = tid >> 4;
    const size_t t0 = (size_t)b * SEQ + (size_t)o8 * 8 * LCH;
    const bf16 *HL = (const bf16*)(ws + WS_HL), *PC = (const bf16*)(ws + WS_PC), *GL = (const bf16*)(ws + WS_GL); bf16* Y = (bf16*)(ws + WS_Y);
    v4u hv[4], pv[4], gv[4];
#define P3_LOAD(PS0) { _Pragma("unroll") for (int q = 0; q < 4; ++q) { const size_t off = (t0 + ((PS0) + q) * 32 + row) * W + g * GD + c8; \
        hv[q] = __builtin_nontemporal_load((const v4u*)(HL + off)); pv[q] = __builtin_nontemporal_load((const v4u*)(PC + off)); gv[q] = __builtin_nontemporal_load((const v4u*)(GL + off)); } }
    P3_LOAD(0)
    {
      const int c = tid & 127, part = tid >> 7; LAS float* pa = hin + 1024; LAS float* ph = hin + 1536;
      const int kbeg = part * 2 * o8, n = 2 * o8;
      float ak[14], hk[14];
#pragma unroll
      for (int i = 0; i < 14; ++i) { const int k = i < n ? kbeg + i : 0; ak[i] = AA[(size_t)k * W + c]; hk[i] = HA[(size_t)k * W + c]; }
      float H = 0.f, A = 1.f;
#pragma unroll
      for (int i = 0; i < 14; ++i) if (i < n) { H = ak[i] * H + hk[i]; A *= ak[i]; }
      pa[part * 128 + c] = A; ph[part * 128 + c] = H;
      float a8[8], h8[8];
#pragma unroll
      for (int k = 0; k < 8; ++k) { a8[k] = AA[(size_t)(8 * o8 + k) * W + c]; h8[k] = HA[(size_t)(8 * o8 + k) * W + c]; }
      __syncthreads();
      if (tid < 128) { float Hc = 0.f;
#pragma unroll
          for (int q = 0; q < 4; ++q) Hc = pa[q * 128 + tid] * Hc + ph[q * 128 + tid];
#pragma unroll
          for (int k = 0; k < 8; ++k) { hin[k * 128 + tid] = Hc; Hc = a8[k] * Hc + h8[k]; } } }
    __syncthreads();
#pragma unroll 1
    for (int pg = 0; pg < 4; ++pg) {
#pragma unroll
        for (int q = 0; q < 4; ++q) { const int tl = (pg * 4 + q) * 32 + row;
            const LAS float* hi = hin + (tl >> 6) * 128 + c8;
            const f32x4 h0 = *(const LAS f32x4*)hi, h1 = *(const LAS f32x4*)(hi + 4);
            const v4u hw = hv[q], pw = pv[q], gw = gv[q];
            float y[8];
            y[0] = (bflo(hw.x) + bflo(pw.x) * h0[0]) * siluf_(bflo(gw.x)); y[1] = (bfhi(hw.x) + bfhi(pw.x) * h0[1]) * siluf_(bfhi(gw.x));
            y[2] = (bflo(hw.y) + bflo(pw.y) * h0[2]) * siluf_(bflo(gw.y)); y[3] = (bfhi(hw.y) + bfhi(pw.y) * h0[3]) * siluf_(bfhi(gw.y));
            y[4] = (bflo(hw.z) + bflo(pw.z) * h1[0]) * siluf_(bflo(gw.z)); y[5] = (bfhi(hw.z) + bfhi(pw.z) * h1[1]) * siluf_(bfhi(gw.z));
            y[6] = (bflo(hw.w) + bflo(pw.w) * h1[2]) * siluf_(bflo(gw.w)); y[7] = (bfhi(hw.w) + bfhi(pw.w) * h1[3]) * siluf_(bfhi(gw.w));
            v4u ov; ov.x = pk2(y[0], y[1]); ov.y = pk2(y[2], y[3]); ov.z = pk2(y[4], y[5]); ov.w = pk2(y[6], y[7]);
            *(v4u*)(Y + (t0 + tl) * (2 * W) + W + g * GD + c8) = ov;
            if (pg < 3) { const size_t off = (t0 + ((pg + 1) * 4 + q) * 32 + row) * W + g * GD + c8;
                hv[q] = __builtin_nontemporal_load((const v4u*)(HL + off)); pv[q] = __builtin_nontemporal_load((const v4u*)(PC + off)); gv[q] = __builtin_nontemporal_load((const v4u*)(GL + off)); } }
    }
#undef P3_LOAD
    __syncthreads();
}

#define XB_TMO      128
#define XB_XCNT(j)  (256  + 64 * (j))
#define XB_XSUB(j)  (1280 + 64 * (j))
#define XB_XGEN(j)  (2304 + 64 * (j))
#define XB_TOP      3328
#define XB_TOPGEN   3392
#define XCD_BAR_WORDS 3456
#define XB_SPIN_CAP (1u << 18)
__device__ __forceinline__ unsigned xb_ld(unsigned* p)              { return __hip_atomic_load(p, __ATOMIC_RELAXED, __HIP_MEMORY_SCOPE_AGENT); }
__device__ __forceinline__ unsigned xb_add(unsigned* p, unsigned v) { return __hip_atomic_fetch_add(p, v, __ATOMIC_RELAXED, __HIP_MEMORY_SCOPE_AGENT); }
__device__ __forceinline__ unsigned xb_xcc_id() { return (unsigned)__builtin_amdgcn_s_getreg((3 << 11) | 20) & 0xFu; }
#define XB_SPIN(cond, bar) do { unsigned _sp = 0; while (cond) { __builtin_amdgcn_s_sleep(1); \
    if ((++_sp & 255u) == 0u) { if (xb_ld(&(bar)[XB_TMO])) break; if (_sp > XB_SPIN_CAP) { atomicAdd(&(bar)[XB_TMO], 1u); break; } } } } while (0)
struct XcdBarrier { unsigned* bar; unsigned x; volatile LAS unsigned* st; };
__device__ __forceinline__ XcdBarrier xcd_barrier_post(unsigned* bar, volatile LAS unsigned* st) {
    XcdBarrier b; b.bar = bar; b.x = xb_xcc_id(); b.st = st;
    if (threadIdx.x == 0) (void)xb_add(&bar[XB_XCNT(b.x)], 1u);
    return b;
}
__device__ __forceinline__ void xcd_barrier_complete(unsigned* bar, unsigned x, unsigned& nloc, unsigned& nx) {
    const unsigned G = gridDim.x * gridDim.y * gridDim.z;
    unsigned sum, cnt, mine, sp = 0u;
    for (;;) {
        sum = 0u; cnt = 0u; mine = 0u;
#pragma unroll
        for (unsigned j = 0; j < 16; ++j) { const unsigned c = xb_ld(&bar[XB_XCNT(j)]); sum += c; cnt += (c > 0u) ? 1u : 0u; mine = (j == x) ? c : mine; }
        if (sum == G) break;
        __builtin_amdgcn_s_sleep(1);
        if ((++sp & 255u) == 0u) { if (xb_ld(&bar[XB_TMO])) break; if (sp > XB_SPIN_CAP) { atomicAdd(&bar[XB_TMO], 1u); break; } }
    }
    nloc = mine > 0u ? mine : 1u; nx = cnt > 0u ? cnt : 1u;
}
__device__ __forceinline__ void xcd_barrier(const XcdBarrier& b) {
    asm volatile("s_waitcnt vmcnt(0)" ::: "memory");
    __syncthreads();
    if (threadIdx.x == 0) {
        unsigned* bar = b.bar;
        __builtin_amdgcn_s_waitcnt(0);
        unsigned nloc = b.st[0], nx = b.st[1];
        if (nloc == 0u) { xcd_barrier_complete(bar, b.x, nloc, nx); b.st[0] = nloc; b.st[1] = nx; }
        const unsigned old = xb_add(&bar[XB_XSUB(b.x)], 1u);
        const unsigned gen = old / nloc;
        if (old + 1u == (gen + 1u) * nloc) {
            __builtin_amdgcn_fence(__ATOMIC_RELEASE, "agent");
            asm volatile("s_waitcnt vmcnt(0)" ::: "memory");
            const unsigned og = xb_add(&bar[XB_TOP], 1u);
            const unsigned tg = og / nx;
            if (og + 1u == (tg + 1u) * nx) xb_add(&bar[XB_TOPGEN], 1u);
            else XB_SPIN(xb_ld(&bar[XB_TOPGEN]) == tg, bar);
            __builtin_amdgcn_fence(__ATOMIC_ACQUIRE, "agent");
            xb_add(&bar[XB_XGEN(b.x)], 1u);
            asm volatile("s_waitcnt vmcnt(0)" ::: "memory");
        } else {
            XB_SPIN(xb_ld(&bar[XB_XGEN(b.x)]) == gen, bar);
            __builtin_amdgcn_fence(__ATOMIC_ACQUIRE, "agent");
            asm volatile("s_waitcnt vmcnt(0)" ::: "memory");
        }
    }
    __syncthreads();
}

#ifndef MK_MULTI
#define MK_MULTI 0
#endif
constexpr int NPHASE = 5;
__global__ void __launch_bounds__(NTHR, 2) hybrid_fwd(Args args) {
    extern __shared__ __attribute__((aligned(16))) unsigned char lds_raw[];
    LAS unsigned char* lds = (LAS unsigned char*)lds_raw;
    const int tid = threadIdx.x, lane = tid & 63, wave = __builtin_amdgcn_readfirstlane(tid >> 6);
    const int lo = args.ph_lo, hi = args.ph_hi;
    unsigned char* ws = args.ws;
#define IN(k) (lo <= (k) && (k) < hi)
    volatile LAS unsigned* misc = (volatile LAS unsigned*)(lds + MISC_OFF);
    if (tid < 4) misc[tid] = 0u;
    __syncthreads();
    const XcdBarrier gbar = xcd_barrier_post((unsigned*)(ws + WS_BAR), misc);
    if (lo < 0) cg::this_grid().sync();
#define SEAM(k) do { if (IN(k) && IN((k) + 1)) { xcd_barrier(gbar); } } while (0)
    if (IN(0)) { p0_prep(args, lds, wave, lane); }
    SEAM(0);
    if (IN(1)) {
        { pg8::Gemm g{(const pg8::bf16_t*)(ws + WS_XN), (const pg8::bf16_t*)(ws + WS_WIN), T, DIN, DM};
          pg8::InProjOrder S; S.init(T, DIN - W, gridDim.x, (int)blockIdx.x);
          static_assert(WS_K - WS_Q == 32 * MiB && WS_GSB - WS_Q == 3 * 32 * MiB && WS_XL - WS_Q == 4 * 32 * MiB && WS_GL - WS_Q == 5 * 32 * MiB, "segment outputs are evenly spaced");
          pg8::EpiInProj E; E.out0 = (pg8::bf16_t*)(ws + WS_Q); E.seg_stride = 16 * MiB;
          E.qg = args.in[3]; E.kg = args.in[4]; E.P = (LAS float*)(lds + PTAB_OFF); E.qscale = QSCALE; E.eps = EPS;
          pg8::gemm_phase<pg8::EpiInProj, pg8::InProjOrder, true, true>(lds, g, S, E); }
        {
          pg8::Gemm g{(const pg8::bf16_t*)(ws + WS_WIN) + (size_t)2 * W * DM, (const pg8::bf16_t*)(ws + WS_XN), W, T, DM};
          pg8::StaticOrder S; S.init(W, T, gridDim.x, (int)blockIdx.x);
          pg8::EpiVt E{(pg8::bf16_t*)(ws + WS_VT)};
          pg8::gemm_phase<pg8::EpiVt, pg8::StaticOrder, true, true>(lds, g, S, E); }
    }
    SEAM(1);
    if (IN(2)) {
        if ((blockIdx.x >> 3) & 1) { p2_lru(args, lds, tid, wave, lane); p2_attention(args, lds, wave, lane); }
        else { p2_attention(args, lds, wave, lane); __syncthreads(); p2_lru(args, lds, tid, wave, lane); }
    }
    SEAM(2);
    if (IN(3)) { for (int it = blockIdx.x; it < BATCH * NG * 8; it += gridDim.x) p3_item(args, lds, it, tid); }
    SEAM(3);
    if (IN(4)) {
        pg8::Gemm g{(const pg8::bf16_t*)(ws + WS_Y), (const pg8::bf16_t*)(ws + WS_WOUT), T, DM, 2 * W};
        pg8::StaticOrder S; S.init(T, DM, gridDim.x, (int)blockIdx.x);
        pg8::EpiResF32 E{args.out, args.in[0], DM};
        pg8::gemm_phase<pg8::EpiResF32, pg8::StaticOrder, true, true>(lds, g, S, E);
    }
#undef IN
#undef SEAM
}

extern "C" void kernel_launch(void* const* d_in, const int* in_sizes, int n_in, void* d_out, int out_size, void* d_ws, size_t ws_size, hipStream_t stream) {
    static int grid = 0;
    if (grid == 0) {
        if (n_in != 13 || ws_size < WS_END) { fprintf(stderr, "kernel_launch: unexpected inputs (n_in %d, ws %zu)\n", n_in, ws_size); grid = -1; return; }
        int dev = 0, cus = 0, per_cu = 0;
        (void)hipGetDevice(&dev); (void)hipDeviceGetAttribute(&cus, hipDeviceAttributeMultiprocessorCount, dev);
        if (hipFuncSetAttribute((const void*)hybrid_fwd, hipFuncAttributeMaxDynamicSharedMemorySize, LDS_BYTES) != hipSuccess) { fprintf(stderr, "kernel_launch: hipFuncSetAttribute failed\n"); grid = -1; return; }
        if (hipOccupancyMaxActiveBlocksPerMultiprocessor(&per_cu, (const void*)hybrid_fwd, NTHR, LDS_BYTES) != hipSuccess || per_cu < 1) { fprintf(stderr, "kernel_launch: occupancy query says %d blocks/CU\n", per_cu); per_cu = 1; }
        (void)hipGetLastError();
        grid = cus;
    }
    if (grid < 0) return;
    if (hipMemsetAsync((char*)d_ws + WS_BAR, 0, BAR_BYTES, stream) != hipSuccess) { fprintf(stderr, "kernel_launch: memset of barrier words failed\n"); return; }
    Args a{};
    for (int i = 0; i < 13; ++i) a.in[i] = (const float*)d_in[i];
    a.out = (float*)d_out; a.ws = (unsigned char*)d_ws;
#if MK_MULTI
    for (int p = 0; p < NPHASE; ++p) { a.ph_lo = p; a.ph_hi = p + 1; hipLaunchKernelGGL(hybrid_fwd, dim3(grid), dim3(NTHR), LDS_BYTES, stream, a); }
#else
    a.ph_lo = 0; a.ph_hi = NPHASE;
    void* kargs[] = {&a};
    hipError_t e = hipLaunchCooperativeKernel((const void*)hybrid_fwd, dim3(grid), dim3(NTHR), kargs, LDS_BYTES, stream);
    if (e != hipSuccess) fprintf(stderr, "cooperative launch failed: %s (grid %d)\n", hipGetErrorString(e), grid);
#endif
}
```
